# Optimizing an MI355X kernel written in HIP

```python
import math
import jax, jax.numpy as jnp
from jax import lax
import numpy as np

D_MODEL = 1024
BATCH = 16
SEQ = 2048
DEPTH = 4

HEAD_DIM_A = 128
KV_HEADS_A = 4
DILATED_GROUPS = ((128, 1), (512, 4), (2048, 16))
N_GROUPS_A = len(DILATED_GROUPS)
Q_HEADS_A = KV_HEADS_A * N_GROUPS_A
ROPE_THETA = 10000.0
GLA_HEADS = 4
GLA_DK = D_MODEL // 2 // GLA_HEADS
GLA_DV = D_MODEL // GLA_HEADS
GLA_LOWRANK = 16
GLA_GATE_TEMP = 16.0
GLA_CHUNK = 64
D_FF = -(-8 * D_MODEL // (3 * 256)) * 256
EPS = 1e-6

W_QA = Q_HEADS_A * HEAD_DIM_A
W_KA = KV_HEADS_A * HEAD_DIM_A
W_VA = KV_HEADS_A * HEAD_DIM_A
W_QB = GLA_HEADS * GLA_DK
W_KB = GLA_HEADS * GLA_DK
W_VB = GLA_HEADS * GLA_DV
W_RB = GLA_HEADS * GLA_DV
IN_SPLITS = (W_QA, W_KA, W_VA, W_QB, W_KB, W_VB, W_RB, GLA_LOWRANK, D_MODEL, D_MODEL)
D_IN = sum(IN_SPLITS)
D_OUT_A = W_VA
D_OUT_B = W_VB

kernel_name = "hybrid_dilated_attn_gla_swiglu"


def rmsnorm(x, g):
    xf = x.astype(jnp.float32)
    y = xf * lax.rsqrt(jnp.mean(xf * xf, axis=-1, keepdims=True) + EPS) * g.astype(jnp.float32)
    return y.astype(x.dtype)


def rope_tables(positions):
    inv_freq = ROPE_THETA ** (-jnp.arange(0, HEAD_DIM_A, 2, dtype=jnp.float32) / HEAD_DIM_A)
    ang = positions.astype(jnp.float32)[..., None] * inv_freq
    return jnp.cos(ang)[:, :, None, :], jnp.sin(ang)[:, :, None, :]


def apply_rope(t, cos, sin):
    tf = t.astype(jnp.float32)
    t1, t2 = jnp.split(tf, 2, axis=-1)
    return jnp.concatenate([t1 * cos - t2 * sin, t2 * cos + t1 * sin], axis=-1).astype(t.dtype)


def dilated_group(q, k, v, window, dilation):
    B, S, H, hd = q.shape
    nk = window // dilation
    L = S // dilation
    nb = -(-L // nk)
    Lp = nb * nk

    def to_blocks(t):
        t = t.astype(jnp.float32).reshape(B, L, dilation, H, hd).transpose(0, 2, 3, 1, 4)
        t = jnp.pad(t, ((0, 0), (0, 0), (0, 0), (0, Lp - L), (0, 0)))
        return t.reshape(B, dilation, H, nb, nk, hd)

    def with_prev(t):
        prev = jnp.pad(t, ((0, 0), (0, 0), (0, 0), (1, 0), (0, 0), (0, 0)))[:, :, :, :-1]
        return jnp.concatenate([prev, t], axis=4)

    qb = to_blocks(q)
    kb = with_prev(to_blocks(k))
    vb = with_prev(to_blocks(v))
    s = jnp.einsum('brhnqe,brhnke->brhnqk', qb, kb)
    qi = jnp.arange(nk)[:, None] + nk
    ki = jnp.arange(2 * nk)[None, :]
    dist = qi - ki
    blk = jnp.arange(nb)[:, None, None]
    valid = (dist >= 0) & (dist <= nk) & (blk * nk + ki - nk >= 0)
    s = jnp.where(valid, s, -jnp.inf)
    m = jnp.max(s, axis=-1, keepdims=True)
    p = jnp.exp(s - m)
    den = jnp.sum(p, axis=-1)
    o = jnp.einsum('brhnqk,brhnke->brhnqe', p, vb) / den[..., None]
    lse = m[..., 0] + jnp.log(den)
    o = o.reshape(B, dilation, H, Lp, hd)[:, :, :, :L].transpose(0, 3, 1, 2, 4).reshape(B, S, H, hd)
    lse = lse.reshape(B, dilation, H, Lp)[:, :, :, :L].transpose(0, 3, 1, 2).reshape(B, S, H)
    return o, lse


def dilated_attention(q, k, v):
    outs, lses = [], []
    for g, (window, dilation) in enumerate(DILATED_GROUPS):
        o, lse = dilated_group(q[:, :, g], k, v, window, dilation)
        outs.append(o)
        lses.append(lse)
    w = jax.nn.softmax(jnp.stack(lses, axis=0), axis=0)
    o = jnp.sum(w[..., None] * jnp.stack(outs, axis=0), axis=0)
    return o.astype(v.dtype)


def gla(q, k, v, log_a):
    B, S, H, dk = q.shape
    dv = v.shape[-1]
    nc = S // GLA_CHUNK

    def to_chunks(t):
        return t.astype(jnp.float32).reshape(B, nc, GLA_CHUNK, H, -1).transpose(1, 0, 3, 2, 4)

    qc, kc, vc = to_chunks(q), to_chunks(k), to_chunks(v)
    bc = jnp.cumsum(to_chunks(log_a), axis=3)
    causal = jnp.tril(jnp.ones((GLA_CHUNK, GLA_CHUNK), dtype=bool))[:, :, None]

    def step(state, xs):
        qi, ki, vi, bi = xs
        b_last = bi[:, :, -1:, :]
        inter = jnp.einsum('bhtd,bhde->bhte', qi * jnp.exp(bi), state)
        diff = bi[:, :, :, None, :] - bi[:, :, None, :, :]
        decay = jnp.exp(jnp.where(causal, diff, -jnp.inf))
        att = jnp.einsum('bhtd,bhsd,bhtsd->bhts', qi, ki, decay)
        intra = jnp.einsum('bhts,bhse->bhte', att, vi)
        new_state = jnp.exp(b_last[:, :, 0, :])[..., None] * state + jnp.einsum(
            'bhsd,bhse->bhde', ki * jnp.exp(b_last - bi), vi)
        return new_state, inter + intra

    state0 = jnp.zeros((B, H, dk, dv), jnp.float32)
    _, o = lax.scan(step, state0, (qc, kc, vc, bc))
    return o.transpose(1, 0, 3, 2, 4).reshape(B, S, H, dv).astype(v.dtype)


def hybrid_layer(x, cos, sin, norm1, w_in, qn_a, kn_a, w_a_up, b_a, gn_b,
                 w_proj_a, w_proj_b, w_out, norm2, w_ffn_gate, w_ffn_up, w_ffn_down):
    B, S, _ = x.shape
    h = rmsnorm(x, norm1)
    proj = h @ w_in
    offsets = np.cumsum(IN_SPLITS)[:-1].tolist()
    qa, ka, va, qb, kb, vb, rb, ab, ga, gb = jnp.split(proj, offsets, axis=-1)

    qa = apply_rope(rmsnorm(qa.reshape(B, S, Q_HEADS_A, HEAD_DIM_A), qn_a), cos, sin) * (HEAD_DIM_A ** -0.5)
    ka = apply_rope(rmsnorm(ka.reshape(B, S, KV_HEADS_A, HEAD_DIM_A), kn_a), cos, sin)
    va = va.reshape(B, S, KV_HEADS_A, HEAD_DIM_A)
    oa = dilated_attention(qa.reshape(B, S, N_GROUPS_A, KV_HEADS_A, HEAD_DIM_A), ka, va)
    oa = oa.reshape(B, S, D_OUT_A)

    qb = qb.reshape(B, S, GLA_HEADS, GLA_DK) * (GLA_DK ** -0.5)
    kb = kb.reshape(B, S, GLA_HEADS, GLA_DK)
    vb = vb.reshape(B, S, GLA_HEADS, GLA_DV)
    log_a = jax.nn.log_sigmoid((ab @ w_a_up + b_a).astype(jnp.float32)) / GLA_GATE_TEMP
    ob = gla(qb, kb, vb, log_a.reshape(B, S, GLA_HEADS, GLA_DK))
    ob = rmsnorm(ob, gn_b) * jax.nn.silu(rb.reshape(B, S, GLA_HEADS, GLA_DV))
    ob = ob.reshape(B, S, D_OUT_B)

    y = jax.nn.sigmoid(ga) * (oa @ w_proj_a) + jax.nn.sigmoid(gb) * (ob @ w_proj_b)
    x = x + y @ w_out

    h2 = rmsnorm(x, norm2)
    x = x + (jax.nn.silu(h2 @ w_ffn_gate) * (h2 @ w_ffn_up)) @ w_ffn_down
    return x


def setup_inputs(seed: int = 0) -> dict:
    key = jax.random.key(seed)
    ks = jax.random.split(key, 20)
    f32 = jnp.float32

    def nrm(k, shape, scale):
        return jax.random.normal(k, shape, f32) * scale

    L = DEPTH
    return {
        "x": jax.random.normal(ks[0], (BATCH, SEQ, D_MODEL), f32),
        "positions": jax.random.randint(ks[1], (BATCH, 1), 0, 4096, dtype=jnp.int32)
                     + jnp.arange(SEQ, dtype=jnp.int32)[None, :],
        "norm1": 1.0 + nrm(ks[2], (L, D_MODEL), 0.05),
        "w_in": nrm(ks[3], (L, D_MODEL, D_IN), D_MODEL ** -0.5),
        "qn_a": 1.0 + nrm(ks[4], (L, HEAD_DIM_A), 0.05),
        "kn_a": 1.0 + nrm(ks[5], (L, HEAD_DIM_A), 0.05),
        "w_a_up": nrm(ks[6], (L, GLA_LOWRANK, W_KB), GLA_LOWRANK ** -0.5),
        "b_a": nrm(ks[7], (L, W_KB), 0.1),
        "gn_b": 1.0 + nrm(ks[8], (L, GLA_DV), 0.05),
        "w_proj_a": nrm(ks[9], (L, D_OUT_A, D_MODEL), D_OUT_A ** -0.5),
        "w_proj_b": nrm(ks[10], (L, D_OUT_B, D_MODEL), D_OUT_B ** -0.5),
        "w_out": nrm(ks[11], (L, D_MODEL, D_MODEL), 0.5 * D_MODEL ** -0.5),
        "norm2": 1.0 + nrm(ks[12], (L, D_MODEL), 0.05),
        "w_ffn_gate": nrm(ks[13], (L, D_MODEL, D_FF), D_MODEL ** -0.5),
        "w_ffn_up": nrm(ks[14], (L, D_MODEL, D_FF), D_MODEL ** -0.5),
        "w_ffn_down": nrm(ks[15], (L, D_FF, D_MODEL), 0.5 * D_FF ** -0.5),
    }


def reference(x, positions, norm1, w_in, qn_a, kn_a, w_a_up, b_a, gn_b, w_proj_a, w_proj_b,
              w_out, norm2, w_ffn_gate, w_ffn_up, w_ffn_down):
    cos, sin = rope_tables(positions)
    for l in range(DEPTH):
        x = hybrid_layer(x, cos, sin, norm1[l], w_in[l], qn_a[l], kn_a[l], w_a_up[l], b_a[l], gn_b[l],
                         w_proj_a[l], w_proj_b[l], w_out[l], norm2[l], w_ffn_gate[l], w_ffn_up[l],
                         w_ffn_down[l])
    return x
```

```cpp
#include <hip/hip_runtime.h>
#include <hip/hip_cooperative_groups.h>
#include <cstdio>
#include <cstdint>
namespace cg = cooperative_groups;

namespace pg8 {
#define PG8_LAS __attribute__((address_space(3)))
typedef unsigned short bf16_t;
typedef short bf16x8 __attribute__((ext_vector_type(8)));
typedef float f32x4 __attribute__((ext_vector_type(4)));
typedef unsigned u32x4 __attribute__((ext_vector_type(4)));
constexpr int BM = 256, BK = 64, HALF = 128, HTB = HALF * BK * 2  , STAGE_BYTES = 8 * HTB, NXCD = 8, WGM = 8;

__host__ __device__ __forceinline__ int lds_byte(int r, int c) { const int st = (r >> 4) * 2 + (c >> 5), rr = r & 15, cc = c & 31, ob = rr * 64 + cc * 2; return st * 1024 + (ob ^ (((ob >> 9) & 1) << 5)); }
__host__ __device__ __forceinline__ void stage_rc(int b, int& R, int& C) { const int st = b / 1024, sb = b % 1024, swz = sb ^ (((sb >> 9) & 1) << 5); R = (st >> 1) * 16 + swz / 64; C = (st & 1) * 32 + (swz % 64) / 2; }
__host__ __device__ __forceinline__ int perm32(int rho) { const int n = rho >> 4, i = rho & 15; return 8 * (i >> 2) + 4 * n + (i & 3); }

struct Unit { int pm, pn; };
struct Gemm { const bf16_t* A; const bf16_t* Bt; int M, N, K; };

struct StaticOrder {
    int nM, nN, nwg, G, c;
    __host__ __device__ void init(int M, int N, int G_, int c_) { nM = M / BM; nN = N / BM; nwg = nM * nN; G = G_; c = c_; }
    __host__ __device__ bool next(int i, Unit& u) const {
        const long L = (long)i * G + c; if (L >= nwg) return false;
        int wgid = (int)L; { const int q = nwg / NXCD, r = nwg % NXCD, xcd = wgid % NXCD, off = wgid / NXCD; wgid = (xcd < r ? xcd * (q + 1) : r * (q + 1) + (xcd - r) * q) + off; }
        const int nig = WGM * nN, gid = wgid / nig, fm = gid * WGM, gsz = (nM - fm) < WGM ? (nM - fm) : WGM;
        u.pm = fm + ((wgid % nig) % gsz); u.pn = (wgid % nig) / gsz; return true;
    }
    __device__ __forceinline__ void a_ready(const Unit&) const {}
    __device__ __forceinline__ void done(const Unit&) const {}
};

typedef unsigned u32x2 __attribute__((ext_vector_type(2)));
typedef float f32x2 __attribute__((ext_vector_type(2)));
typedef __bf16 bf16x2_t __attribute__((ext_vector_type(2)));
constexpr float EPS_ = 1e-6f;
constexpr int T_ = 32768;
__device__ __forceinline__ unsigned pk2(float lo, float hi) { f32x2 v = {lo, hi}; bf16x2_t b = __builtin_convertvector(v, bf16x2_t); return __builtin_bit_cast(unsigned, b); }
__device__ __forceinline__ u32x4 pk8(f32x4 a, f32x4 b) { u32x4 w; w.x = pk2(a[0], a[1]); w.y = pk2(a[2], a[3]); w.z = pk2(b[0], b[1]); w.w = pk2(b[2], b[3]); return w; }
__device__ __forceinline__ float bflo(unsigned w) { return __uint_as_float(w << 16); }
__device__ __forceinline__ float bfhi(unsigned w) { return __uint_as_float(w & 0xffff0000u); }
__device__ __forceinline__ void unpk8(u32x4 w, f32x4& a, f32x4& b) { a = (f32x4){bflo(w.x), bfhi(w.x), bflo(w.y), bfhi(w.y)}; b = (f32x4){bflo(w.z), bfhi(w.z), bflo(w.w), bfhi(w.w)}; }
__device__ __forceinline__ float sigm(float x) { return __builtin_amdgcn_rcpf(1.f + __expf(-x)); }
__device__ __forceinline__ f32x4 sigm4(f32x4 v) { return (f32x4){sigm(v[0]), sigm(v[1]), sigm(v[2]), sigm(v[3])}; }
__device__ __forceinline__ f32x4 silu4(f32x4 v) { return v * sigm4(v); }
__device__ __forceinline__ float rowscale(const float* rowss, int row) { const f32x4* p = (const f32x4*)(rowss + (size_t)row * 16); const f32x4 a = p[0], b = p[1], c = p[2], d = p[3];
    const float s = (((a[0] + a[1]) + (a[2] + a[3])) + ((b[0] + b[1]) + (b[2] + b[3]))) + (((c[0] + c[1]) + (c[2] + c[3])) + ((d[0] + d[1]) + (d[2] + d[3])));
    return rsqrtf(s * (1.f / 1024.f) + EPS_); }
__device__ __forceinline__ void stage_rowscale(PG8_LAS float* RS, const float* rowss, int pm) {
    int t = threadIdx.x; asm volatile("" : "+v"(t));
    if (t < 256) RS[t] = rowscale(rowss, pm * 256 + t);
    asm volatile("s_waitcnt lgkmcnt(0)" ::: "memory"); __builtin_amdgcn_s_barrier(); asm volatile("" ::: "memory");
}
#define EPI_ROWS(ai, m) _Pragma("unroll") for (int ai = 0; ai < 2; ++ai) _Pragma("unroll") for (int m = 0; m < 4; ++m)
#define EPI_FENCE(m) do { if ((m) & 1) asm volatile("" ::: "memory"); } while (0)

struct EpiInA {
    static constexpr bool PERM = true, AFTER_DRAIN = false;
    bf16_t* out; const float* rowss; const float* qn; const float* kn; const float* rope; PG8_LAS float* P; float qscale;
    __device__ __forceinline__ void operator()(const f32x4 (&acc)[2][2][4][2], const Unit& u, int wr, int wc, int fr, int fq) const {
        int rl0 = wr * 64 + fr; asm volatile("" : "+v"(rl0)); const int col0 = u.pn * 256 + wc * 32 + 8 * fq;
        stage_rowscale(P + 2048, rowss, u.pm);
        if (u.pn < 8) {
            EPI_ROWS(ai, m) { const int rl = ai * 128 + rl0 + m * 16; const float rs = P[2048 + rl];
#pragma unroll
                for (int bj = 0; bj < 2; ++bj) { const f32x4 a = acc[ai][bj][m][0] * rs, b = acc[ai][bj][m][1] * rs;
                    float ss = (a[0] * a[0] + a[1] * a[1]) + (a[2] * a[2] + a[3] * a[3]) + (b[0] * b[0] + b[1] * b[1]) + (b[2] * b[2] + b[3] * b[3]);
                    ss += __shfl_xor(ss, 16); ss += __shfl_xor(ss, 32);
                    if (fq == 0) P[rl * 8 + bj * 4 + wc] = ss; }
                EPI_FENCE(m); }
            asm volatile("s_waitcnt lgkmcnt(0)" ::: "memory"); __builtin_amdgcn_s_barrier(); asm volatile("" ::: "memory");
            const float* gp = (u.pn < 6) ? qn : kn; const float sc = (u.pn < 6) ? qscale : 1.f;
            const f32x4 g0 = *(const f32x4*)(gp + 16 * wc + 4 * fq) * sc, g1 = *(const f32x4*)(gp + 64 + 16 * wc + 4 * fq) * sc;
            EPI_ROWS(ai, m) { const int rl = ai * 128 + rl0 + m * 16; const int row = u.pm * 256 + rl; const float rs = P[2048 + rl];
                const u32x4 cw = *(const u32x4*)((const unsigned*)rope + (size_t)row * 64 + 16 * wc + 4 * fq);
#define H2F_LO(w_) ((float)__builtin_bit_cast(_Float16, (unsigned short)((w_) & 0xffffu)))
#define H2F_HI(w_) ((float)__builtin_bit_cast(_Float16, (unsigned short)((w_) >> 16)))
                const f32x4 cs = {H2F_LO(cw[0]), H2F_LO(cw[1]), H2F_LO(cw[2]), H2F_LO(cw[3])}, sn = {H2F_HI(cw[0]), H2F_HI(cw[1]), H2F_HI(cw[2]), H2F_HI(cw[3])};
#pragma unroll
                for (int bj = 0; bj < 2; ++bj) { const f32x4 pp = *(const PG8_LAS f32x4*)(P + rl * 8 + bj * 4);
                    const float hn = rsqrtf(((pp[0] + pp[1]) + (pp[2] + pp[3])) * (1.f / 128.f) + EPS_) * rs;
                    const f32x4 x1 = acc[ai][bj][m][0] * hn * g0, x2 = acc[ai][bj][m][1] * hn * g1;
                    const f32x4 o1 = x1 * cs - x2 * sn, o2 = x2 * cs + x1 * sn;
                    *(u32x4*)(out + (size_t)row * 2560 + col0 + bj * 128) = pk8(o1, o2); } asm volatile("" ::: "memory"); }
        } else {
            EPI_ROWS(ai, m) { const int rl = ai * 128 + rl0 + m * 16; const int row = u.pm * 256 + rl; const float rs = P[2048 + rl];
#pragma unroll
                for (int bj = 0; bj < 2; ++bj) *(u32x4*)(out + (size_t)row * 2560 + col0 + bj * 128) = pk8(acc[ai][bj][m][0] * rs, acc[ai][bj][m][1] * rs); EPI_FENCE(m); }
        }
    }
};
struct EpiInB {
    static constexpr bool PERM = true, AFTER_DRAIN = false;
    bf16_t* out; bf16_t* rb; float* ab; const float* rowss; PG8_LAS float* RS;
    __device__ __forceinline__ void operator()(const f32x4 (&acc)[2][2][4][2], const Unit& u, int wr, int wc, int fr, int fq) const {
        int rl0 = wr * 64 + fr; asm volatile("" : "+v"(rl0)); const int cin = wc * 32 + 8 * fq;
        stage_rowscale(RS, rowss, u.pm);
        EPI_ROWS(ai, m) { const int rl = ai * 128 + rl0 + m * 16; const int row = u.pm * 256 + rl; float rs = RS[rl];
            if (u.pn < 8) { if (u.pn < 2) rs *= 0.08838834764831845f;
#pragma unroll
                for (int bj = 0; bj < 2; ++bj) *(u32x4*)(out + (size_t)row * 2048 + u.pn * 256 + cin + bj * 128) = pk8(acc[ai][bj][m][0] * rs, acc[ai][bj][m][1] * rs);
            } else if (u.pn < 12) {
#pragma unroll
                for (int bj = 0; bj < 2; ++bj) *(u32x4*)(rb + (size_t)row * 1024 + (u.pn - 8) * 256 + cin + bj * 128) = pk8(silu4(acc[ai][bj][m][0] * rs), silu4(acc[ai][bj][m][1] * rs));
            } else if (wc == 0 && fq < 2) {
                *(f32x4*)(ab + (size_t)row * 16 + 8 * fq) = acc[ai][0][m][0] * rs; *(f32x4*)(ab + (size_t)row * 16 + 8 * fq + 4) = acc[ai][0][m][1] * rs;
            } EPI_FENCE(m); }
    }
};
struct EpiInC {
    static constexpr bool PERM = true, AFTER_DRAIN = false;
    bf16_t* ga; bf16_t* gb; const float* rowss; PG8_LAS float* RS;
    __device__ __forceinline__ void operator()(const f32x4 (&acc)[2][2][4][2], const Unit& u, int wr, int wc, int fr, int fq) const {
        int rl0 = wr * 64 + fr; asm volatile("" : "+v"(rl0)); bf16_t* base = (u.pn < 4) ? ga : gb; const int col0 = (u.pn & 3) * 256 + wc * 32 + 8 * fq;
        stage_rowscale(RS, rowss, u.pm);
        EPI_ROWS(ai, m) { const int rl = ai * 128 + rl0 + m * 16; const int row = u.pm * 256 + rl; const float rs = RS[rl];
#pragma unroll
            for (int bj = 0; bj < 2; ++bj) *(u32x4*)(base + (size_t)row * 1024 + col0 + bj * 128) = pk8(sigm4(acc[ai][bj][m][0] * rs), sigm4(acc[ai][bj][m][1] * rs)); EPI_FENCE(m); }
    }
};
template <int MODE> struct EpiProj {
    static constexpr bool PERM = true, AFTER_DRAIN = false;
    bf16_t* y; const bf16_t* gb;
    __device__ __forceinline__ void operator()(const f32x4 (&acc)[2][2][4][2], const Unit& u, int wr, int wc, int fr, int fq) const {
        int rl0 = wr * 64 + fr; asm volatile("" : "+v"(rl0)); const int col0 = u.pn * 256 + wc * 32 + 8 * fq;
        EPI_ROWS(ai, m) { const int row = u.pm * 256 + ai * 128 + rl0 + m * 16;
#pragma unroll
            for (int bj = 0; bj < 2; ++bj) { const size_t off = (size_t)row * 1024 + col0 + bj * 128; f32x4 a, b; unpk8(*(const u32x4*)(y + off), a, b);
                if (MODE == 0) { a = a * acc[ai][bj][m][0]; b = b * acc[ai][bj][m][1]; }
                else { f32x4 c, d; unpk8(*(const u32x4*)(gb + off), c, d); a = a + c * acc[ai][bj][m][0]; b = b + d * acc[ai][bj][m][1]; }
                *(u32x4*)(y + off) = pk8(a, b); } EPI_FENCE(m); }
    }
};
struct EpiRes {
    static constexpr bool PERM = true, AFTER_DRAIN = false;
    const float* xin; float* xout; bf16_t* xb; float* ssout; int last;
    __device__ __forceinline__ void operator()(const f32x4 (&acc)[2][2][4][2], const Unit& u, int wr, int wc, int fr, int fq) const {
        int rl0 = wr * 64 + fr; asm volatile("" : "+v"(rl0)); const int col0 = u.pn * 256 + wc * 32 + 8 * fq;
        EPI_ROWS(ai, m) { const int row = u.pm * 256 + ai * 128 + rl0 + m * 16; float ss = 0.f;
#pragma unroll
            for (int bj = 0; bj < 2; ++bj) { const size_t off = (size_t)row * 1024 + col0 + bj * 128;
                const f32x4 a = *(const f32x4*)(xin + off) + acc[ai][bj][m][0], b = *(const f32x4*)(xin + off + 4) + acc[ai][bj][m][1];
                *(f32x4*)(xout + off) = a; *(f32x4*)(xout + off + 4) = b; if (!last) *(u32x4*)(xb + off) = pk8(a, b);
                ss += (a[0] * a[0] + a[1] * a[1]) + (a[2] * a[2] + a[3] * a[3]) + (b[0] * b[0] + b[1] * b[1]) + (b[2] * b[2] + b[3] * b[3]); }
            ss += __shfl_xor(ss, 16); ss += __shfl_xor(ss, 32);
            if (fq == 0 && !last) ssout[(size_t)row * 16 + u.pn * 4 + wc] = ss; EPI_FENCE(m); }
    }
};
struct EpiFFN {
    static constexpr bool PERM = true, AFTER_DRAIN = false;
    bf16_t* hb; const float* rowss; PG8_LAS float* RS;
    __device__ __forceinline__ void operator()(const f32x4 (&acc)[2][2][4][2], const Unit& u, int wr, int wc, int fr, int fq) const {
        int rl0 = wr * 64 + fr; asm volatile("" : "+v"(rl0)); const int col0 = u.pn * 128 + wc * 32 + 8 * fq;
        stage_rowscale(RS, rowss, u.pm);
        EPI_ROWS(ai, m) { const int rl = ai * 128 + rl0 + m * 16; const int row = u.pm * 256 + rl; const float rs = RS[rl];
            const f32x4 a = silu4(acc[ai][0][m][0] * rs) * (acc[ai][1][m][0] * rs), b = silu4(acc[ai][0][m][1] * rs) * (acc[ai][1][m][1] * rs);
            *(u32x4*)(hb + (size_t)row * 2816 + col0) = pk8(a, b); EPI_FENCE(m); }
    }
};
template <class Epi, class Sched, bool ALIGN_EPI = false, bool SP2 = false>
__device__ __forceinline__ void gemm_phase(PG8_LAS unsigned char* lds, const Gemm g, const Sched& S, const Epi& E) {
    int tid_raw = threadIdx.x; asm volatile("" : "+v"(tid_raw));
    const int tid = tid_raw, wid = __builtin_amdgcn_readfirstlane(tid >> 6), lane = tid & 63, wr = wid >> 2, wc = wid & 3, fr = lane & 15, fq = lane >> 4;
    const int K = g.K, nt = K / BK;
    unsigned voffA[2], voffB[2];
#pragma unroll
    for (int i = 0; i < 2; ++i) { int R, C; stage_rc(tid * 16 + i * 8192, R, C); const int Rb = Epi::PERM ? ((R & ~31) + perm32(R & 31)) : R;
        voffA[i] = (unsigned)(R * K + C) * 2u; voffB[i] = (unsigned)(Rb * K + C) * 2u; }
    const size_t kstep = (size_t)(BK * 2);
    const size_t hstep = (size_t)HALF * K * 2;
    const size_t tstep = 2 * hstep;
    const unsigned ldsw = (unsigned)wid * 1024u;
    const int aoff = lds_byte(wr * 64 + fr, fq * 8), boff = lds_byte(wc * 32 + fr, fq * 8);
#define PG8_SA(b, h) (((b) * 2 + (h)) * HTB)
#define PG8_SB(b, h) ((4 + (b) * 2 + (h)) * HTB)
#define PG8_STAGE(bufoff, gbase, voff) do { _Pragma("unroll") for (int _i = 0; _i < 2; ++_i) \
        __builtin_amdgcn_global_load_lds((const unsigned*)((const char*)(gbase) + (voff)[_i]), (PG8_LAS unsigned*)(lds + (bufoff) + ldsw + _i * 8192), 16, 0, 0); } while (0)
#define PG8_LDA(dst, b, h) do { _Pragma("unroll") for (int m = 0; m < 4; ++m) _Pragma("unroll") for (int k = 0; k < 2; ++k) dst[m][k] = *(const PG8_LAS bf16x8*)(lds + PG8_SA(b, h) + aoff + m * 2048 + k * 1024); } while (0)
#define PG8_LDB(dst, b, h) do { _Pragma("unroll") for (int n = 0; n < 2; ++n) _Pragma("unroll") for (int k = 0; k < 2; ++k) dst[n][k] = *(const PG8_LAS bf16x8*)(lds + PG8_SB(b, h) + boff + n * 2048 + k * 1024); } while (0)
#define PG8_MMA(ai, bj, At, Bt) do { __builtin_amdgcn_s_setprio(1); _Pragma("unroll") for (int m = 0; m < 4; ++m) _Pragma("unroll") for (int n = 0; n < 2; ++n) _Pragma("unroll") for (int k = 0; k < 2; ++k) \
        acc[ai][bj][m][n] = __builtin_amdgcn_mfma_f32_16x16x32_bf16(Bt[n][k], At[m][k], acc[ai][bj][m][n], 0, 0, 0); __builtin_amdgcn_s_setprio(0); } while (0)
#define PG8_WAIT_V(n) asm volatile("s_waitcnt vmcnt(" #n ")" ::: "memory")
#define PG8_WAIT_L(n) asm volatile("s_waitcnt lgkmcnt(" #n ")" ::: "memory")
#define PG8_BAR __builtin_amdgcn_s_barrier()
#define PG8_SCHED __builtin_amdgcn_sched_barrier(0)
    Unit cur, nxt; int ui = 0;
    if (!S.next(0, cur)) return;
    f32x4 acc[2][2][4][2];
#pragma unroll
    for (int a = 0; a < 2; ++a)
#pragma unroll
        for (int b = 0; b < 2; ++b)
#pragma unroll
            for (int m = 0; m < 4; ++m)
#pragma unroll
                for (int n = 0; n < 2; ++n) acc[a][b][m][n] = (f32x4){0.f, 0.f, 0.f, 0.f};
    bf16x8 At[4][2], B0[2][2], B1[2][2];
    const char* cA = (const char*)g.A + (size_t)cur.pm * tstep; const char* cB = (const char*)g.Bt + (size_t)cur.pn * tstep;
    S.a_ready(cur);
    if constexpr (SP2) {
        PG8_STAGE(PG8_SB(0, 0), cB, voffB); PG8_STAGE(PG8_SB(0, 1), cB + hstep, voffB); PG8_STAGE(PG8_SA(0, 0), cA, voffA); PG8_STAGE(PG8_SA(0, 1), cA + hstep, voffA);
        if (wr == 1) PG8_BAR;
        PG8_WAIT_V(2); PG8_BAR;
        PG8_STAGE(PG8_SB(1, 0), cB + kstep, voffB); PG8_STAGE(PG8_SA(1, 0), cA + kstep, voffA); PG8_STAGE(PG8_SB(1, 1), cB + hstep + kstep, voffB);
        PG8_WAIT_V(6); PG8_BAR;
    } else {
        PG8_STAGE(PG8_SB(0, 0), cB, voffB); PG8_STAGE(PG8_SA(0, 0), cA, voffA); PG8_STAGE(PG8_SB(0, 1), cB + hstep, voffB); PG8_STAGE(PG8_SA(0, 1), cA + hstep, voffA);
        if (wr == 1) PG8_BAR;
        PG8_WAIT_V(4); PG8_BAR;
        PG8_STAGE(PG8_SB(1, 0), cB + kstep, voffB); PG8_STAGE(PG8_SA(1, 0), cA + kstep, voffA); PG8_STAGE(PG8_SB(1, 1), cB + hstep + kstep, voffB);
        PG8_WAIT_V(6); PG8_BAR;
    }
    for (;;) {
        const bool has_next = S.next(ui + 1, nxt);
        const char* nA = has_next ? (const char*)g.A + (size_t)nxt.pm * tstep : cA; const char* nB = has_next ? (const char*)g.Bt + (size_t)nxt.pn * tstep : cB;
        for (int t = 0; t < nt; t += 2) {
            const bool last = (t == nt - 2);
            const char* a1 = cA + (size_t)(t + 1) * kstep;
            const char* a2 = last ? nA : cA + (size_t)(t + 2) * kstep; const char* b2 = last ? nB : cB + (size_t)(t + 2) * kstep;
            const char* a3 = a2 + kstep; const char* b3 = b2 + kstep;
            if (last && has_next) S.a_ready(nxt);
            if constexpr (SP2) {
            PG8_LDB(B0, 0, 0); PG8_LDB(B1, 0, 1); PG8_SCHED; PG8_LDA(At, 0, 0); PG8_STAGE(PG8_SA(1, 1), a1 + hstep, voffA);
            PG8_WAIT_V(8); PG8_WAIT_L(0); PG8_BAR; PG8_MMA(0, 0, At, B0); PG8_MMA(0, 1, At, B1); PG8_BAR; PG8_SCHED;
            PG8_LDA(At, 0, 1); PG8_STAGE(PG8_SB(0, 0), b2, voffB); PG8_STAGE(PG8_SB(0, 1), b2 + hstep, voffB); PG8_STAGE(PG8_SA(0, 0), a2, voffA);
            PG8_WAIT_V(8); PG8_WAIT_L(0); PG8_BAR; PG8_MMA(1, 0, At, B0); PG8_MMA(1, 1, At, B1); PG8_BAR; PG8_SCHED;
            PG8_LDB(B0, 1, 0); PG8_LDB(B1, 1, 1); PG8_SCHED; PG8_LDA(At, 1, 0); PG8_STAGE(PG8_SA(0, 1), a2 + hstep, voffA);
            PG8_WAIT_V(8); PG8_WAIT_L(0); PG8_BAR; PG8_MMA(0, 0, At, B0); PG8_MMA(0, 1, At, B1); PG8_BAR; PG8_SCHED;
            PG8_LDA(At, 1, 1); PG8_STAGE(PG8_SB(1, 0), b3, voffB); PG8_STAGE(PG8_SB(1, 1), b3 + hstep, voffB); PG8_STAGE(PG8_SA(1, 0), a3, voffA);
            PG8_WAIT_V(8); PG8_WAIT_L(0); PG8_BAR; PG8_MMA(1, 0, At, B0); PG8_MMA(1, 1, At, B1); PG8_BAR; PG8_SCHED;
            } else {
            PG8_LDB(B0, 0, 0); PG8_SCHED; PG8_LDA(At, 0, 0); PG8_STAGE(PG8_SA(1, 1), a1 + hstep, voffA);
            PG8_WAIT_L(8); PG8_BAR; PG8_WAIT_L(0); PG8_MMA(0, 0, At, B0); PG8_BAR; PG8_SCHED;
            PG8_LDB(B1, 0, 1); PG8_STAGE(PG8_SB(0, 0), b2, voffB);
            PG8_BAR; PG8_WAIT_L(0); PG8_MMA(0, 1, At, B1); PG8_BAR;
            PG8_LDA(At, 0, 1); PG8_STAGE(PG8_SA(0, 0), a2, voffA);
            PG8_BAR; PG8_WAIT_L(0); PG8_MMA(1, 0, At, B0); PG8_BAR; PG8_SCHED;
            PG8_STAGE(PG8_SB(0, 1), b2 + hstep, voffB);
            PG8_WAIT_V(6); PG8_BAR; PG8_MMA(1, 1, At, B1); PG8_BAR;
            PG8_LDB(B0, 1, 0); PG8_SCHED; PG8_LDA(At, 1, 0); PG8_STAGE(PG8_SA(0, 1), a2 + hstep, voffA);
            PG8_WAIT_L(8); PG8_BAR; PG8_WAIT_L(0); PG8_MMA(0, 0, At, B0); PG8_BAR; PG8_SCHED;
            PG8_LDB(B1, 1, 1); PG8_STAGE(PG8_SB(1, 0), b3, voffB);
            PG8_BAR; PG8_WAIT_L(0); PG8_MMA(0, 1, At, B1); PG8_BAR;
            PG8_LDA(At, 1, 1); PG8_STAGE(PG8_SA(1, 0), a3, voffA);
            PG8_BAR; PG8_WAIT_L(0); PG8_MMA(1, 0, At, B0); PG8_BAR; PG8_SCHED;
            PG8_STAGE(PG8_SB(1, 1), b3 + hstep, voffB);
            PG8_WAIT_V(6); PG8_BAR; PG8_MMA(1, 1, At, B1); PG8_BAR;
            }
        }
        if constexpr (ALIGN_EPI) { if (wr == 0) PG8_BAR; }
        if constexpr (!Epi::AFTER_DRAIN) { E(acc, cur, wr, wc, fr, fq); S.done(cur); }
        if (!has_next) break;
#pragma unroll
        for (int a = 0; a < 2; ++a)
#pragma unroll
            for (int b = 0; b < 2; ++b)
#pragma unroll
                for (int m = 0; m < 4; ++m)
#pragma unroll
                    for (int n = 0; n < 2; ++n) acc[a][b][m][n] = (f32x4){0.f, 0.f, 0.f, 0.f};
        cur = nxt; cA = nA; cB = nB; ++ui;
        if constexpr (ALIGN_EPI) { if (wr == 1) PG8_BAR; }
    }
    PG8_WAIT_V(0);
    if constexpr (!ALIGN_EPI) { if (wr == 0) PG8_BAR; }
    PG8_BAR;
    if constexpr (Epi::AFTER_DRAIN) { E.fused(acc, cur, wr, wc, fr, fq, lds, wid, lane); S.done(cur); }
#undef PG8_SA
#undef PG8_SB
#undef PG8_STAGE
#undef PG8_LDA
#undef PG8_LDB
#undef PG8_MMA
#undef PG8_WAIT_V
#undef PG8_WAIT_L
#undef PG8_BAR
#undef PG8_SCHED
}
}
using namespace pg8;
#define LAS __attribute__((address_space(3)))
#define DI __device__ __forceinline__
typedef short s16x4 __attribute__((ext_vector_type(4)));
typedef short v4i16_t __attribute__((ext_vector_type(4)));
typedef float f32x16 __attribute__((ext_vector_type(16)));
constexpr int T = 32768, SEQ = 2048, DEPTH = 4;
constexpr float EPS = 1e-6f;
constexpr float QSCALE = 0.08838834764831845f * 1.4426950408889634f;
constexpr size_t MiB = 1u << 20, HM = 1u << 19;
constexpr size_t W_LAYER = 37 * MiB;
constexpr size_t W_INA = 0, W_INB = 5 * MiB, W_INC = 11 * MiB + HM, W_PA = 15 * MiB + HM, W_PB = 16 * MiB + HM, W_OUT = 18 * MiB + HM, W_GU = 20 * MiB + HM, W_D = 31 * MiB + HM;
constexpr size_t WS_XB = 74 * MiB, WS_R = 138 * MiB;
constexpr size_t R_OG = 0, R_BUFA = 96 * MiB, R_BUFB = 96 * MiB, R_RB = 224 * MiB, R_GA = 32 * MiB, R_GB = 96 * MiB, R_HB = 96 * MiB;
constexpr size_t WS_ROPE = 426 * MiB, WS_AB = 434 * MiB, WS_DEN = 436 * MiB, WS_ROWSS = 438 * MiB, WS_BLG = 442 * MiB, WS_BAR = 443 * MiB, WS_GB = 444 * MiB, WS_END = 508 * MiB;
constexpr int LDS_BYTES = 147456, EPI_LDS = 131072;
struct Args { const float* in[16]; float* out; unsigned char* ws; };

#define MFMA32(a, b, c) __builtin_amdgcn_mfma_f32_32x32x16_bf16((a), (b), (c), 0, 0, 0)
DI int crow(int reg, int h) { return (reg & 3) + 8 * (reg >> 2) + 4 * h; }
DI bf16x8 pack8(const f32x16& x, int s) { u32x4 p; p.x = pk2(x[8 * s], x[8 * s + 1]); p.y = pk2(x[8 * s + 2], x[8 * s + 3]); p.z = pk2(x[8 * s + 4], x[8 * s + 5]); p.w = pk2(x[8 * s + 6], x[8 * s + 7]); return __builtin_bit_cast(bf16x8, p); }
DI s16x4 vtr(const LAS unsigned char* p) { return __builtin_bit_cast(s16x4, __builtin_amdgcn_ds_read_tr16_b64_v4i16((LAS v4i16_t*)p)); }
DI bf16x8 cat8(s16x4 lo, s16x4 hi) { return __builtin_shufflevector(lo, hi, 0, 1, 2, 3, 4, 5, 6, 7); }
DI f32x16 zero16() { float z = 0.f; asm volatile("" : "+v"(z)); f32x16 r;
#pragma unroll
    for (int i = 0; i < 16; ++i) r[i] = z;
    return r; }
DI float wave_sum(float v) {
#pragma unroll
    for (int o = 1; o < 64; o <<= 1) v += __shfl_xor(v, o);
    return v;
}

DI void conv_tile(const float* src, int ldw, int K, int col, const float* ksc, bf16_t* WT, int p0, int k0, LAS float* scr, int lane) {
#pragma unroll 16
    for (int i = 0; i < 32; ++i) { const int kk = 2 * i + (lane >> 5); float v = 0.f;
        if (col >= 0) { v = src[(size_t)(k0 + kk) * ldw + col]; if (ksc) v *= ksc[k0 + kk]; }
        scr[kk * 33 + (lane & 31)] = v; }
    asm volatile("s_waitcnt lgkmcnt(0)" ::: "memory");
    const int c = lane & 7;
#pragma unroll
    for (int j = 0; j < 4; ++j) { const int n = (lane >> 3) + 8 * j; const LAS float* s = scr + (8 * c) * 33 + n;
        u32x4 o; o.x = pk2(s[0 * 33], s[1 * 33]); o.y = pk2(s[2 * 33], s[3 * 33]); o.z = pk2(s[4 * 33], s[5 * 33]); o.w = pk2(s[6 * 33], s[7 * 33]);
        *(u32x4*)(WT + (size_t)(p0 + n) * K + k0 + 8 * c) = o; }
    asm volatile("s_waitcnt lgkmcnt(0)" ::: "memory");
}
constexpr int CONV_ITEMS = 1280 + 1664 + 1024 + 256 + 512 + 512 + 2816 + 1408;
DI void conv_layer(const Args& a, int l, unsigned char* wbytes, LAS float* scr, int gw, int ngw) {
    int lane = threadIdx.x; asm volatile("" : "+v"(lane)); lane &= 63;
    const float* win = a.in[3] + (size_t)l * 1024 * 7696; const float* n1 = a.in[2] + l * 1024; const float* n2 = a.in[12] + l * 1024;
    const int pl = lane & 31;
    for (int it = gw; it < CONV_ITEMS; it += ngw) {
        int r = it;
        if (r < 1280) { const int nb = r % 80, kb = r / 80, p = 32 * nb + pl; int col = p;
            if (p < 2048) { const int w = p & 127, j = w >> 3, e = w & 7; col = (p & ~127) + (e < 4 ? 4 * j + e : 64 + 4 * j + e - 4); }
            conv_tile(win, 7696, 1024, col, n1, (bf16_t*)(wbytes + W_INA), 32 * nb, 64 * kb, scr, lane); continue; }
        r -= 1280;
        if (r < 1664) { const int nb = r % 104, kb = r / 104, p = 32 * nb + pl; const int col = p < 3072 ? 2560 + p : (p < 3088 ? 5632 + (p - 3072) : -1);
            conv_tile(win, 7696, 1024, col, n1, (bf16_t*)(wbytes + W_INB), 32 * nb, 64 * kb, scr, lane); continue; }
        r -= 1664;
        if (r < 1024) { const int nb = r % 64, kb = r / 64, p = 32 * nb + pl;
            conv_tile(win, 7696, 1024, 5648 + p, n1, (bf16_t*)(wbytes + W_INC), 32 * nb, 64 * kb, scr, lane); continue; }
        r -= 1024;
        if (r < 256) { const int nb = r % 32, kb = r / 32;
            conv_tile(a.in[9] + (size_t)l * 512 * 1024, 1024, 512, 32 * nb + pl, nullptr, (bf16_t*)(wbytes + W_PA), 32 * nb, 64 * kb, scr, lane); continue; }
        r -= 256;
        if (r < 512) { const int nb = r % 32, kb = r / 32;
            conv_tile(a.in[10] + (size_t)l * 1024 * 1024, 1024, 1024, 32 * nb + pl, nullptr, (bf16_t*)(wbytes + W_PB), 32 * nb, 64 * kb, scr, lane); continue; }
        r -= 512;
        if (r < 512) { const int nb = r % 32, kb = r / 32;
            conv_tile(a.in[11] + (size_t)l * 1024 * 1024, 1024, 1024, 32 * nb + pl, nullptr, (bf16_t*)(wbytes + W_OUT), 32 * nb, 64 * kb, scr, lane); continue; }
        r -= 512;
        if (r < 2816) { const int nb = r % 176, kb = r / 176, p = 32 * nb + pl, t = p >> 8, c = p & 255;
            const float* src = (c < 128 ? a.in[13] : a.in[14]) + (size_t)l * 1024 * 2816;
            conv_tile(src, 2816, 1024, 128 * t + (c & 127), n2, (bf16_t*)(wbytes + W_GU), 32 * nb, 64 * kb, scr, lane); continue; }
        r -= 2816;
        { const int nb = r % 32, kb = r / 32;
            conv_tile(a.in[15] + (size_t)l * 2816 * 1024, 1024, 2816, 32 * nb + pl, nullptr, (bf16_t*)(wbytes + W_D), 32 * nb, 64 * kb, scr, lane); }
    }
}

struct AttnU { int b, h, g, d, r, nb, jstart; };
DI AttnU attn_decode(int idx) { AttnU u; const int rem = idx % 192, uu = rem & 15; u.b = idx / 192; u.h = rem / 48; u.g = (rem % 48) >> 4; const int sh = 2 * u.g; u.d = 1 << sh; u.r = uu & (u.d - 1); u.nb = uu >> sh; u.jstart = (u.nb == 0) ? 128 : 0; return u; }
DI void attn_phase(LAS unsigned char* lds, const bf16_t* bufA, bf16_t* OG, float* DEN, int bid, int G) {
    int tid_raw = threadIdx.x; asm volatile("" : "+v"(tid_raw));
    const int tid = tid_raw, lane = tid & 63, w = __builtin_amdgcn_readfirstlane(tid >> 6), l31 = lane & 31, h2 = lane >> 5;
    const int qt = w >> 1, dbase = 2 * (w & 1), q4 = (lane & 15) >> 2, p4 = lane & 3, blk = (lane >> 4) & 1;
    LAS unsigned char* Ks = lds; LAS unsigned char* Vs = lds + 65536;
    const int per = (3072 + G - 1) / G, u0 = bid * per, u1 = (u0 + per < 3072) ? u0 + per : 3072;
    u32x4 kreg[8], vreg[8];
#define ATTN_ISSUE(U) do { _Pragma("unroll") for (int it = 0; it < 8; ++it) { const int e = tid + 512 * it, j = e >> 4, ch = e & 15; \
        if (j >= (U).jstart) { const int tk = (((U).nb - 1) * 128 + j) * (U).d + (U).r; const bf16_t* src = bufA + ((size_t)(U).b * SEQ + tk) * 2560 + (U).h * 128 + ch * 8; \
            kreg[it] = *(const u32x4*)(src + 1536); vreg[it] = *(const u32x4*)(src + 2048); } } } while (0)
    if (u0 < u1) { const AttnU un = attn_decode(u0); ATTN_ISSUE(un); }
    for (int idx = u0; idx < u1; ++idx) {
        const AttnU cu = attn_decode(idx);
        const int b = cu.b, h = cu.h, g = cu.g, d = cu.d, r = cu.r, nb = cu.nb, jstart = cu.jstart;
        const size_t rowb = (size_t)b * SEQ;
        const int iq = 32 * qt + l31, tq = (nb * 128 + iq) * d + r;
        const bf16_t* qp = bufA + (rowb + tq) * 2560 + (g * 4 + h) * 128 + 8 * h2;
        bf16x8 qf[8];
#pragma unroll
        for (int ks = 0; ks < 8; ++ks) qf[ks] = *(const bf16x8*)(qp + 16 * ks);
        __syncthreads();
#pragma unroll
        for (int it = 0; it < 8; ++it) { const int e = tid + 512 * it, j = e >> 4, ch = e & 15;
            if (j >= jstart) { const int o = 256 * j + 16 * (ch ^ (j & 15)); *(LAS u32x4*)(Ks + o) = kreg[it]; *(LAS u32x4*)(Vs + o) = vreg[it]; } }
        __syncthreads();
        if (idx + 1 < u1) { const AttnU un = attn_decode(idx + 1); ATTN_ISSUE(un); }
        f32x16 o0 = {}, o1 = {}; float den = 0.f;
        const int kb0 = (jstart >> 5) > qt ? (jstart >> 5) : qt;
        for (int kb = kb0; kb <= qt + 4; ++kb) {
            f32x16 s = zero16();
            const int key = 32 * kb + l31, sw = key & 15; const LAS unsigned char* kr = Ks + 256 * key;
#pragma unroll
            for (int ks = 0; ks < 8; ++ks) { const bf16x8 av = *(const LAS bf16x8*)(kr + 16 * ((2 * ks + h2) ^ sw)); s = MFMA32(av, qf[ks], s); }
            bf16x8 vfr[2][2];
#pragma unroll
            for (int s2 = 0; s2 < 2; ++s2) { const int key0 = 32 * kb + 16 * s2 + 4 * h2 + q4, key1 = key0 + 8;
#pragma unroll
                for (int dbi = 0; dbi < 2; ++dbi) { const int chunk = 4 * (dbase + dbi) + 2 * blk + (p4 >> 1);
                    const s16x4 lo = vtr(Vs + 256 * key0 + 16 * (chunk ^ (key0 & 15)) + 8 * (p4 & 1));
                    const s16x4 hi = vtr(Vs + 256 * key1 + 16 * (chunk ^ (key1 & 15)) + 8 * (p4 & 1)); vfr[s2][dbi] = cat8(lo, hi); } }
            const bool interior = (kb > qt) && (kb < qt + 4);
            if (interior) {
#pragma unroll
                for (int reg = 0; reg < 16; ++reg) { const float p = __builtin_amdgcn_exp2f(s[reg]); s[reg] = p; den += p; }
            } else {
#pragma unroll
                for (int reg = 0; reg < 16; ++reg) { const int j = 32 * kb + crow(reg, h2); const bool ok = (j >= iq) && (j <= iq + 128);
                    const float p = ok ? __builtin_amdgcn_exp2f(s[reg]) : 0.f; s[reg] = p; den += p; }
            }
#pragma unroll
            for (int s2 = 0; s2 < 2; ++s2) { const bf16x8 pb = pack8(s, s2);
                o0 = MFMA32(vfr[s2][0], pb, o0); o1 = MFMA32(vfr[s2][1], pb, o1); }
        }
        den += __shfl_xor(den, 32);
        bf16_t* op = OG + (size_t)g * T * 512 + (rowb + tq) * 512 + h * 128 + 4 * h2;
#pragma unroll
        for (int rg = 0; rg < 4; ++rg) {
            u32x2 v0; v0.x = pk2(o0[4 * rg], o0[4 * rg + 1]); v0.y = pk2(o0[4 * rg + 2], o0[4 * rg + 3]); *(u32x2*)(op + 32 * dbase + 8 * rg) = v0;
            u32x2 v1; v1.x = pk2(o1[4 * rg], o1[4 * rg + 1]); v1.y = pk2(o1[4 * rg + 2], o1[4 * rg + 3]); *(u32x2*)(op + 32 * (dbase + 1) + 8 * rg) = v1; }
        if ((w & 1) == 0 && h2 == 0) DEN[(rowb + tq) * 12 + h * 3 + g] = den;
    }
#undef ATTN_ISSUE
}
DI void combine_pass(bf16_t* OG, const float* DEN, int hid, int HN) {
    const size_t n8 = (size_t)T * 64, G1 = (size_t)T * 512;
    int tid_raw = threadIdx.x; asm volatile("" : "+v"(tid_raw));
    for (size_t i = (size_t)hid * 512 + tid_raw; i < n8; i += (size_t)HN * 512) { const size_t t = i >> 6; const int h = (int)(i & 63) >> 4;
        const float* dp = DEN + t * 12 + h * 3; const float inv = 1.f / (dp[0] + dp[1] + dp[2]);
        f32x4 a0, b0, a1, b1, a2, b2; unpk8(*(const u32x4*)(OG + i * 8), a0, b0); unpk8(*(const u32x4*)(OG + G1 + i * 8), a1, b1); unpk8(*(const u32x4*)(OG + 2 * G1 + i * 8), a2, b2);
        *(u32x4*)(OG + i * 8) = pk8((a0 + a1 + a2) * inv, (b0 + b1 + b2) * inv); }
}


DI u32x4 ld16_agent(const void* p) { const unsigned long long* q = (const unsigned long long*)p;
    const unsigned long long a = __hip_atomic_load(q, __ATOMIC_RELAXED, __HIP_MEMORY_SCOPE_AGENT), b = __hip_atomic_load(q + 1, __ATOMIC_RELAXED, __HIP_MEMORY_SCOPE_AGENT);
    return (u32x4){(unsigned)a, (unsigned)(a >> 32), (unsigned)b, (unsigned)(b >> 32)}; }
DI unsigned ld2_agent(const bf16_t* p) { return (unsigned)__hip_atomic_load(p, __ATOMIC_RELAXED, __HIP_MEMORY_SCOPE_AGENT); }
constexpr int G_QT = 0, G_KT = 16384, G_VT = 32768, G_OST = 65536, G_ABS = 98304, G_SEG = 102400, G_BL = 104448, G_GN = 104960, G_WU = 105984;
constexpr int GLA_UNITS = 64 * 32;
DI void gla1_phase(LAS unsigned char* lds, bf16_t* bufB, const float* ABUF, const float* wup, const float* ba, float* BLG, int bid, int G) {
    int tid_raw = threadIdx.x; asm volatile("" : "+v"(tid_raw));
#define GLA_IDS() int tid = tid_raw; asm volatile("" : "+v"(tid)); const int lane = tid & 63, l31 = lane & 31, h2 = lane >> 5, q4 = (lane & 15) >> 2, p4 = lane & 3, blk = (lane >> 4) & 1, dch = tid & 127, seg = tid >> 7; (void)l31; (void)h2; (void)q4; (void)p4; (void)blk; (void)dch; (void)seg
    LAS unsigned char* QT = lds + G_QT; LAS unsigned char* KT = lds + G_KT; LAS unsigned char* OST = lds + G_OST;
    LAS float* ABS = (LAS float*)(lds + G_ABS); LAS float* SEG = (LAS float*)(lds + G_SEG); LAS float* WU = (LAS float*)(lds + G_WU);
    int hprev = -1;
    f32x2 p_ab = {0.f, 0.f}; u32x4 p_q[2], p_k[2];
#define GLA1_ISSUE(UN) do { int t_ = tid_raw; asm volatile("" : "+v"(t_)); const int st_ = (UN) >> 5, c_ = (UN) & 31, b_ = st_ >> 2, h_ = st_ & 3; const size_t tk_ = (size_t)b_ * SEQ + c_ * 64; \
        p_ab = *(const f32x2*)(ABUF + tk_ * 16 + 2 * t_); \
        _Pragma("unroll") for (int i = 0; i < 2; ++i) { const int e = t_ + 512 * i, row = e >> 4, ch = e & 15; const bf16_t* src = bufB + (tk_ + row) * 2048 + h_ * 128 + ch * 8; p_q[i] = *(const u32x4*)src; p_k[i] = *(const u32x4*)(src + 512); } } while (0)
    if (bid < GLA_UNITS) GLA1_ISSUE(bid);
#pragma nounroll
    for (int unit = bid; unit < GLA_UNITS; unit += G) {
        const int st = unit >> 5, c = unit & 31, b = st >> 2, h = st & 3;
        const size_t tok0 = (size_t)b * SEQ + c * 64;
        __syncthreads();
        if (h != hprev) { GLA_IDS(); hprev = h;
            if (tid < 128) {
#pragma unroll
                for (int r = 0; r < 16; ++r) WU[r * 128 + tid] = wup[r * 512 + h * 128 + tid];
                WU[16 * 128 + tid] = ba[h * 128 + tid]; } }
        { GLA_IDS();
        *(LAS f32x2*)(ABS + 2 * tid) = p_ab;
#pragma unroll
        for (int i = 0; i < 2; ++i) { const int e = tid + 512 * i, row = e >> 4, ch = e & 15; *(LAS u32x4*)(OST + 256 * row + 16 * ch) = p_q[i]; *(LAS u32x4*)(OST + 16384 + 256 * row + 16 * ch) = p_k[i]; }
        __syncthreads();
        if (unit + G < GLA_UNITS) GLA1_ISSUE(unit + G);
        unsigned qk[16];
#pragma unroll
        for (int i = 0; i < 16; ++i) { const int o2 = 256 * (16 * seg + i) + 2 * dch; qk[i] = (unsigned)*(const LAS unsigned short*)(OST + o2) | ((unsigned)*(const LAS unsigned short*)(OST + 16384 + o2) << 16); }
        float cum[16]; float run = 0.f; float zz[16];
#pragma unroll
        for (int i = 0; i < 16; ++i) zz[i] = WU[16 * 128 + dch];
#pragma unroll
        for (int r4 = 0; r4 < 4; ++r4) { const float w0 = WU[(4 * r4) * 128 + dch], w1 = WU[(4 * r4 + 1) * 128 + dch], w2 = WU[(4 * r4 + 2) * 128 + dch], w3 = WU[(4 * r4 + 3) * 128 + dch];
#pragma unroll
            for (int i = 0; i < 16; ++i) { const f32x4 av = *(const LAS f32x4*)(ABS + (16 * seg + i) * 16 + 4 * r4); zz[i] += (av[0] * w0 + av[1] * w1) + (av[2] * w2 + av[3] * w3); } }
#pragma unroll
        for (int i = 0; i < 16; ++i) { const float z = zz[i];
            const float la = (fminf(z, 0.f) - __logf(1.f + __expf(-fabsf(z)))) * 0.0625f; run += la; cum[i] = run; }
        SEG[seg * 128 + dch] = run;
        __syncthreads();
        float pre = 0.f, tot = 0.f;
#pragma unroll
        for (int s_ = 0; s_ < 4; ++s_) { const float v = SEG[s_ * 128 + dch]; tot += v; if (s_ < seg) pre += v; }
#pragma unroll
        for (int i = 0; i < 16; ++i) { const int t = 16 * seg + i; const float bi = pre + cum[i]; const float eb = __expf(bi), ebi = __builtin_amdgcn_rcpf(eb);
            const float qv = __uint_as_float(qk[i] << 16), kv = __uint_as_float(qk[i] & 0xffff0000u);
            const int o = 256 * t + 16 * ((dch >> 3) ^ (t & 15)) + 2 * (dch & 7);
            const unsigned me = pk2(qv * eb, kv * ebi), nb = (unsigned)__shfl_xor((int)me, 1);
            if (!(dch & 1)) { *(LAS unsigned*)(QT + o) = (me & 0xffffu) | (nb << 16); *(LAS unsigned*)(KT + o) = (me >> 16) | (nb & 0xffff0000u); } }
        if (seg == 3) BLG[(size_t)unit * 128 + dch] = __expf(tot);
        __syncthreads();
#pragma unroll
        for (int i = 0; i < 2; ++i) { const int e = tid + 512 * i, row = e >> 4, ch = e & 15; bf16_t* dst = bufB + (tok0 + row) * 2048 + h * 128 + ch * 8;
            *(u32x4*)dst = *(const LAS u32x4*)(QT + 256 * row + 16 * ch); *(u32x4*)(dst + 512) = *(const LAS u32x4*)(KT + 256 * row + 16 * ch); } }
    }
#undef GLA1_ISSUE
#undef GLA_IDS
}
DI void gla2_phase(LAS unsigned char* lds, const bf16_t* bufB, bf16_t* RB, const float* BLG, const float* gn, int bid, int G) {
    int tid_raw = threadIdx.x; asm volatile("" : "+v"(tid_raw));
    const int w = __builtin_amdgcn_readfirstlane(tid_raw >> 6);
#define GLA_IDS() int tid = tid_raw; asm volatile("" : "+v"(tid)); const int lane = tid & 63, l31 = lane & 31, h2 = lane >> 5, q4 = (lane & 15) >> 2, p4 = lane & 3, blk = (lane >> 4) & 1; (void)l31; (void)h2; (void)q4; (void)p4; (void)blk
    LAS unsigned char* QT = lds + G_QT; LAS unsigned char* KT = lds + G_KT; LAS unsigned char* VT = lds + G_VT; LAS unsigned char* OST = lds + G_OST;
    LAS float* BL = (LAS float*)(lds + G_BL); LAS float* GN = (LAS float*)(lds + G_GN);
    for (int st = bid; st < 64; st += G) {
        const int b = st >> 2, h = st & 3;
        __syncthreads();
        { GLA_IDS(); if (tid < 256) GN[tid] = gn[tid]; }
        f32x16 S[4];
#pragma unroll
        for (int i = 0; i < 4; ++i) S[i] = (f32x16){};
        u32x4 pq[2], pk[2], pv[4]; float pa = 0.f;
        { GLA_IDS(); const size_t tok0 = (size_t)b * SEQ;
#pragma unroll
            for (int i = 0; i < 2; ++i) { const int e = tid + 512 * i, row = e >> 4, ch = e & 15; const bf16_t* src = bufB + (tok0 + row) * 2048 + h * 128 + ch * 8; pq[i] = *(const u32x4*)src; pk[i] = *(const u32x4*)(src + 512); }
#pragma unroll
            for (int i = 0; i < 4; ++i) { const int e = tid + 512 * i, row = e >> 5, ch = e & 31; pv[i] = *(const u32x4*)(bufB + (tok0 + row) * 2048 + 1024 + h * 256 + ch * 8); }
            if (tid < 128) pa = BLG[(size_t)(st * 32) * 128 + tid]; }
#pragma nounroll
        for (int c = 0; c < 32; ++c) {
            const size_t tok0 = (size_t)b * SEQ + c * 64;
            u32x4 gate[4];
            { GLA_IDS();
#pragma unroll
            for (int i = 0; i < 2; ++i) { const int e = tid + 512 * i, row = e >> 4, ch = e & 15; *(LAS u32x4*)(QT + 256 * row + 16 * ch) = pq[i]; *(LAS u32x4*)(KT + 256 * row + 16 * ch) = pk[i]; }
#pragma unroll
            for (int i = 0; i < 4; ++i) { const int e = tid + 512 * i, row = e >> 5, ch = e & 31; *(LAS u32x4*)(VT + 512 * row + 16 * (ch ^ (row & 15))) = pv[i]; }
            if (tid < 128) BL[tid] = pa;
            __syncthreads();
            if (c + 1 < 32) { const size_t tn = tok0 + 64;
#pragma unroll
                for (int i = 0; i < 2; ++i) { const int e = tid + 512 * i, row = e >> 4, ch = e & 15; const bf16_t* src = bufB + (tn + row) * 2048 + h * 128 + ch * 8; pq[i] = *(const u32x4*)src; pk[i] = *(const u32x4*)(src + 512); }
#pragma unroll
                for (int i = 0; i < 4; ++i) { const int e = tid + 512 * i, row = e >> 5, ch = e & 31; pv[i] = *(const u32x4*)(bufB + (tn + row) * 2048 + 1024 + h * 256 + ch * 8); }
                if (tid < 128) pa = BLG[(size_t)(st * 32 + c + 1) * 128 + tid]; }
            bf16x8 vf[4];
#pragma unroll
            for (int k4 = 0; k4 < 4; ++k4) { const int row0 = 16 * k4 + 4 * h2 + q4, row1 = row0 + 8, chunk = 4 * w + 2 * blk + (p4 >> 1);
                const s16x4 lo = vtr(VT + 512 * row0 + 16 * (chunk ^ (row0 & 15)) + 8 * (p4 & 1));
                const s16x4 hi = vtr(VT + 512 * row1 + 16 * (chunk ^ (row1 & 15)) + 8 * (p4 & 1)); vf[k4] = cat8(lo, hi); }
#pragma unroll
            for (int tb = 0; tb < 2; ++tb) {
                f32x16 acc = zero16();
                const int t = 32 * tb + l31, tsw = t & 15; const LAS unsigned char* qrow = QT + 256 * t;
#pragma unroll
                for (int dkb = 0; dkb < 4; ++dkb) { const bf16x8 sf0 = pack8(S[dkb], 0), sf1 = pack8(S[dkb], 1);
#pragma unroll
                    for (int ks = 0; ks < 2; ++ks) { const int ch0 = 4 * dkb + 2 * ks;
                        const s16x4 lo = *(const LAS s16x4*)(qrow + 16 * (ch0 ^ tsw) + 8 * h2), hi = *(const LAS s16x4*)(qrow + 16 * ((ch0 + 1) ^ tsw) + 8 * h2);
                        acc = MFMA32(cat8(lo, hi), ks == 0 ? sf0 : sf1, acc); } }
#pragma unroll
                for (int sb = 0; sb <= tb; ++sb) { f32x16 X = zero16(); const int srow = 32 * sb + l31, ssw = srow & 15; const LAS unsigned char* krow_ = KT + 256 * srow;
#pragma unroll
                    for (int ks = 0; ks < 8; ++ks) { const bf16x8 av = *(const LAS bf16x8*)(krow_ + 16 * ((2 * ks + h2) ^ ssw)), bv = *(const LAS bf16x8*)(qrow + 16 * ((2 * ks + h2) ^ tsw)); X = MFMA32(av, bv, X); }
                    if (sb == tb) {
#pragma unroll
                        for (int reg = 0; reg < 16; ++reg) if (crow(reg, h2) > l31) X[reg] = 0.f; }
                    acc = MFMA32(pack8(X, 0), vf[2 * sb], acc); acc = MFMA32(pack8(X, 1), vf[2 * sb + 1], acc); }
#pragma unroll
                for (int reg = 0; reg < 16; ++reg) *(LAS unsigned short*)(OST + 512 * (32 * tb + crow(reg, h2)) + 2 * (32 * w + l31)) = (unsigned short)pk2(acc[reg], 0.f);
            }
            { const int t = tid >> 3, s8 = tid & 7; const bf16_t* rp = RB + (tok0 + t) * 1024 + h * 256 + 32 * s8;
#pragma unroll
                for (int i = 0; i < 4; ++i) gate[i] = *(const u32x4*)(rp + 8 * i); }
#pragma unroll
            for (int dkb = 0; dkb < 4; ++dkb) {
#pragma unroll
                for (int k4 = 0; k4 < 4; ++k4) { const int key0 = 16 * k4 + 4 * h2 + q4, key1 = key0 + 8, chunk = 4 * dkb + 2 * blk + (p4 >> 1);
                    const s16x4 lo = vtr(KT + 256 * key0 + 16 * (chunk ^ (key0 & 15)) + 8 * (p4 & 1));
                    const s16x4 hi = vtr(KT + 256 * key1 + 16 * (chunk ^ (key1 & 15)) + 8 * (p4 & 1));
                    S[dkb] = MFMA32(cat8(lo, hi), vf[k4], S[dkb]); }
#pragma unroll
                for (int rg = 0; rg < 4; ++rg) { const f32x4 dv = *(const LAS f32x4*)(BL + 32 * dkb + 8 * rg + 4 * h2);
                    S[dkb][4 * rg] *= dv[0]; S[dkb][4 * rg + 1] *= dv[1]; S[dkb][4 * rg + 2] *= dv[2]; S[dkb][4 * rg + 3] *= dv[3]; }
            }
            }
            __syncthreads();
            { GLA_IDS(); const int t = tid >> 3, s8 = tid & 7; const LAS u32x4* orow = (const LAS u32x4*)(OST + 512 * t + 64 * s8);
                f32x4 ov[8]; float ss = 0.f;
#pragma unroll
                for (int i = 0; i < 4; ++i) { unpk8(orow[i], ov[2 * i], ov[2 * i + 1]); }
#pragma unroll
                for (int i = 0; i < 8; ++i) ss += (ov[i][0] * ov[i][0] + ov[i][1] * ov[i][1]) + (ov[i][2] * ov[i][2] + ov[i][3] * ov[i][3]);
                ss += __shfl_xor(ss, 1); ss += __shfl_xor(ss, 2); ss += __shfl_xor(ss, 4);
                const float rn = rsqrtf(ss * (1.f / 256.f) + EPS);
                bf16_t* rp = RB + (tok0 + t) * 1024 + h * 256 + 32 * s8;
#pragma unroll
                for (int i = 0; i < 4; ++i) { f32x4 ra, rb2; unpk8(gate[i], ra, rb2);
                    const f32x4 g0 = *(const LAS f32x4*)(GN + 32 * s8 + 8 * i), g1 = *(const LAS f32x4*)(GN + 32 * s8 + 8 * i + 4);
                    *(u32x4*)(rp + 8 * i) = pk8(ov[2 * i] * rn * g0 * ra, ov[2 * i + 1] * rn * g1 * rb2); } }
        }
    }
#undef GLA_IDS
}
#define XB_TMO      128
#define XB_XCNT(j)  (256  + 64 * (j))
#define XB_XSUB(j)  (1280 + 64 * (j))
#define XB_XGEN(j)  (2304 + 64 * (j))
#define XB_TOP      3328
#define XB_TOPGEN   3392
#define XCD_BAR_WORDS 3456
#define XB_SPIN_CAP (1u << 18)

__device__ __forceinline__ unsigned xb_ld(unsigned* p)              { return __hip_atomic_load(p, __ATOMIC_RELAXED, __HIP_MEMORY_SCOPE_AGENT); }
__device__ __forceinline__ unsigned xb_add(unsigned* p, unsigned v) { return __hip_atomic_fetch_add(p, v, __ATOMIC_RELAXED, __HIP_MEMORY_SCOPE_AGENT); }
__device__ __forceinline__ unsigned xb_xcc_id() { return (unsigned)__builtin_amdgcn_s_getreg((3 << 11) | 20) & 0xFu; }
#define XB_SPIN(cond, bar) do { unsigned _sp = 0; while (cond) { __builtin_amdgcn_s_sleep(1); \
    if ((++_sp & 255u) == 0u) { if (xb_ld(&(bar)[XB_TMO])) break; if (_sp > XB_SPIN_CAP) { atomicAdd(&(bar)[XB_TMO], 1u); break; } } } } while (0)

struct XcdBarrier {
    unsigned* bar; unsigned x;
    volatile LAS unsigned* st;
};

__device__ __forceinline__ XcdBarrier xcd_barrier_post(unsigned* bar, volatile LAS unsigned* st) {
    XcdBarrier b; b.bar = bar; b.x = xb_xcc_id(); b.st = st;
    if (threadIdx.x == 0) (void)xb_add(&bar[XB_XCNT(b.x)], 1u);
    return b;
}
__device__ __forceinline__ void xcd_barrier_complete(unsigned* bar, unsigned x, unsigned& nloc, unsigned& nx) {
    const unsigned G = gridDim.x * gridDim.y * gridDim.z;
    unsigned sum, cnt, mine, sp = 0u;
    for (;;) {
        sum = 0u; cnt = 0u; mine = 0u;
#pragma unroll
        for (unsigned j = 0; j < 16; ++j) { const unsigned c = xb_ld(&bar[XB_XCNT(j)]); sum += c; cnt += (c > 0u) ? 1u : 0u; mine = (j == x) ? c : mine; }
        if (sum == G) break;
        __builtin_amdgcn_s_sleep(1);
        if ((++sp & 255u) == 0u) { if (xb_ld(&bar[XB_TMO])) break; if (sp > XB_SPIN_CAP) { atomicAdd(&bar[XB_TMO], 1u); break; } }
    }
    nloc = mine > 0u ? mine : 1u; nx = cnt > 0u ? cnt : 1u;
}

__device__ __forceinline__ void xcd_barrier(const XcdBarrier& b) {
    asm volatile("s_waitcnt vmcnt(0)" ::: "memory");
    __syncthreads();
    if (threadIdx.x == 0) {
        unsigned* bar = b.bar;
        __builtin_amdgcn_s_waitcnt(0);
        unsigned nloc = b.st[0], nx = b.st[1];
        if (nloc == 0u) { xcd_barrier_complete(bar, b.x, nloc, nx); b.st[0] = nloc; b.st[1] = nx; }
        const unsigned old = xb_add(&bar[XB_XSUB(b.x)], 1u);
        const unsigned gen = old / nloc;
        if (old + 1u == (gen + 1u) * nloc) {
            __builtin_amdgcn_fence(__ATOMIC_RELEASE, "agent");
            asm volatile("s_waitcnt vmcnt(0)" ::: "memory");
            const unsigned og = xb_add(&bar[XB_TOP], 1u);
            const unsigned tg = og / nx;
            if (og + 1u == (tg + 1u) * nx) xb_add(&bar[XB_TOPGEN], 1u);
            else XB_SPIN(xb_ld(&bar[XB_TOPGEN]) == tg, bar);
            __builtin_amdgcn_fence(__ATOMIC_ACQUIRE, "agent");
            xb_add(&bar[XB_XGEN(b.x)], 1u);
            asm volatile("s_waitcnt vmcnt(0)" ::: "memory");
        } else {
            XB_SPIN(xb_ld(&bar[XB_XGEN(b.x)]) == gen, bar);
            __builtin_amdgcn_fence(__ATOMIC_ACQUIRE, "agent");
            asm volatile("s_waitcnt vmcnt(0)" ::: "memory");
        }
    }
    __syncthreads();
}

__global__ void __launch_bounds__(512, 2) hybrid_fwd(Args a) {
    extern __shared__ __attribute__((aligned(16))) unsigned char lds_raw[];
    LAS unsigned char* lds = (LAS unsigned char*)lds_raw;
    cg::grid_group grid = cg::this_grid();
#define GRID_SYNC_CG() do { asm volatile("s_waitcnt vmcnt(0)" ::: "memory"); grid.sync(); asm volatile("s_waitcnt vmcnt(0)" ::: "memory"); __builtin_amdgcn_s_barrier(); asm volatile("" ::: "memory"); } while (0)
#define GRID_SYNC() xcd_barrier(xbar)
    const int wave = __builtin_amdgcn_readfirstlane((int)threadIdx.x >> 6);
    const int bid = blockIdx.x, G = gridDim.x;
    volatile LAS unsigned* xst = (volatile LAS unsigned*)(lds + LDS_BYTES - 64);
    if (threadIdx.x < 2) xst[threadIdx.x] = 0u;
    if (blockIdx.x == 0) for (int i = threadIdx.x; i < XCD_BAR_WORDS; i += 512) ((unsigned*)(a.ws + WS_BAR))[i] = 0u;
    __syncthreads();
    unsigned char* ws = a.ws;
#define XB ((bf16_t*)(ws + WS_XB))
#define OG ((bf16_t*)(ws + WS_R + R_OG))
#define BUFA ((bf16_t*)(ws + WS_R + R_BUFA))
#define BUFB ((bf16_t*)(ws + WS_R + R_BUFB))
#define RBB ((bf16_t*)(ws + WS_R + R_RB))
#define GA ((bf16_t*)(ws + WS_R + R_GA))
#define GB ((bf16_t*)(ws + WS_GB))
#define HB ((bf16_t*)(ws + WS_R + R_HB))
#define ROPE ((float*)(ws + WS_ROPE))
#define ABUF ((float*)(ws + WS_AB))
#define DEN ((float*)(ws + WS_DEN))
    float* xout = a.out;
    LAS float* cscr = (LAS float*)(lds + wave * 8704);

    {
        float* ROWSS = (float*)(ws + WS_ROWSS);
        int tid = threadIdx.x; asm volatile("" : "+v"(tid)); const int lane = tid & 63;
        const int gw = bid * 8 + wave, ngw = G * 8;
        conv_layer(a, 0, ws, cscr, gw, ngw);
        const float* x = a.in[0];
        for (int m = gw; m < T; m += ngw) { const f32x4* xr = (const f32x4*)(x + (size_t)m * 1024) + lane; float s = 0.f; u32x2* o8 = (u32x2*)(XB + (size_t)m * 1024) + lane;
#pragma unroll
            for (int j = 0; j < 4; ++j) { const f32x4 v = xr[64 * j]; s += (v[0] * v[0] + v[1] * v[1]) + (v[2] * v[2] + v[3] * v[3]); u32x2 o; o.x = pk2(v[0], v[1]); o.y = pk2(v[2], v[3]); o8[64 * j] = o; }
            s = wave_sum(s); if (lane < 16) ROWSS[(size_t)m * 16 + lane] = (lane == 0) ? s : 0.f; }
        const size_t gt = (size_t)bid * 512 + tid, ngt = (size_t)G * 512;
        const int* pos = (const int*)a.in[1];
        for (size_t i = gt; i < (size_t)T * 64; i += ngt) { const int t = (int)(i >> 6), f = (int)(i & 63);
            const float inv_freq = powf(10000.f, -(float)(2 * f) / 128.f); const float ang = (float)pos[t] * inv_freq;
            double rev = (double)ang * 0.15915494309189535; rev -= floor(rev); const float fr = (float)rev;
            typedef _Float16 h2_t __attribute__((ext_vector_type(2))); const h2_t hv = {(_Float16)__builtin_amdgcn_cosf(fr), (_Float16)__builtin_amdgcn_sinf(fr)};
            ((unsigned*)ROPE)[i] = __builtin_bit_cast(unsigned, hv); }
    }
    GRID_SYNC_CG();
    const XcdBarrier xbar = xcd_barrier_post((unsigned*)(a.ws + WS_BAR), xst);

    for (int l0 = 0; l0 < DEPTH; ++l0) {
#define PHASE_PTRS() int l = l0; asm volatile("" : "+s"(l)); unsigned char* wb = ws + (size_t)(l & 1) * W_LAYER; float* ROWSS = (float*)(ws + WS_ROWSS); \
        const float* ss1 = ROWSS; float* ss2 = ROWSS + (size_t)T * 16; float* ss1n = ROWSS; (void)wb; (void)ss1; (void)ss2; (void)ss1n
        { PHASE_PTRS(); Gemm g{XB, (const bf16_t*)(wb + W_INA), T, 2560, 1024}; StaticOrder S; S.init(T, 2560, G, bid);
          EpiInA E{BUFA, ss1, a.in[4] + l * 128, a.in[5] + l * 128, ROPE, (LAS float*)(lds + EPI_LDS), QSCALE};
#ifndef NO_G1
          gemm_phase<EpiInA, StaticOrder, true, true>(lds, g, S, E);
#endif
        }
        GRID_SYNC();
#ifndef NO_ATTN
        attn_phase(lds, (const bf16_t*)(ws + WS_R + R_BUFA), (bf16_t*)(ws + WS_R + R_OG), (float*)(ws + WS_DEN), (G % 8 == 0) ? (bid % 8) * (G / 8) + bid / 8 : bid, G);
#endif
        GRID_SYNC();
        { PHASE_PTRS(); Gemm g{XB, (const bf16_t*)(wb + W_INB), T, 3328, 1024}; StaticOrder S; S.init(T, 3328, G, bid);
          EpiInB E{BUFB, RBB, ABUF, ss1, (LAS float*)(lds + EPI_LDS) + 2048};
#ifndef NO_G2
          gemm_phase<EpiInB, StaticOrder, true, true>(lds, g, S, E);
#endif
        }
        GRID_SYNC();
        { PHASE_PTRS();
          combine_pass(OG, DEN, bid, G);
#ifndef NO_GLA
          gla1_phase(lds, BUFB, ABUF, a.in[6] + (size_t)l * 16 * 512, a.in[7] + l * 512, (float*)(ws + WS_BLG), bid, G);
#endif
        }
        GRID_SYNC();
        { PHASE_PTRS();
#ifndef NO_GLA
        if (G <= 64 || bid < 64) gla2_phase(lds, BUFB, RBB, (const float*)(ws + WS_BLG), a.in[8] + l * 256, bid, G <= 64 ? G : 64);
#endif
        if (G <= 64 || bid >= 64) { const int hid = G <= 64 ? bid : bid - 64, HN = G <= 64 ? G : G - 64;
            __syncthreads();
            if (l + 1 < DEPTH) conv_layer(a, l + 1, ws + (size_t)((l + 1) & 1) * W_LAYER, cscr, hid * 8 + wave, HN * 8);
            __syncthreads();
            Gemm g{XB, (const bf16_t*)(wb + W_INC), T, 2048, 1024}; StaticOrder S; S.init(T, 2048, HN, hid);
            EpiInC E{GA, GB, ss1, (LAS float*)(lds + EPI_LDS) + 2048};
#ifndef NO_G3
            gemm_phase<EpiInC, StaticOrder, true, true>(lds, g, S, E);
#endif
        } }
        GRID_SYNC();
        { PHASE_PTRS(); Gemm g{OG, (const bf16_t*)(wb + W_PA), T, 1024, 512}; StaticOrder S; S.init(T, 1024, G, bid);
          EpiProj<0> E{GA, GB};
#ifndef NO_G4
          gemm_phase<EpiProj<0>, StaticOrder, true, true>(lds, g, S, E);
#endif
        }
        { PHASE_PTRS(); Gemm g{RBB, (const bf16_t*)(wb + W_PB), T, 1024, 1024}; StaticOrder S; S.init(T, 1024, G, bid);
          EpiProj<1> E{GA, GB};
#ifndef NO_G5
          gemm_phase<EpiProj<1>, StaticOrder, true, true>(lds, g, S, E);
#endif
        }
        GRID_SYNC();
        { PHASE_PTRS(); Gemm g{GA, (const bf16_t*)(wb + W_OUT), T, 1024, 1024}; StaticOrder S; S.init(T, 1024, G, bid);
          EpiRes E{l == 0 ? a.in[0] : xout, xout, XB, ss2, 0};
#ifndef NO_G6
          gemm_phase<EpiRes, StaticOrder, true, true>(lds, g, S, E);
#endif
        }
        GRID_SYNC();
        { PHASE_PTRS(); Gemm g{XB, (const bf16_t*)(wb + W_GU), T, 5632, 1024}; StaticOrder S; S.init(T, 5632, G, bid);
          EpiFFN E{HB, ss2, (LAS float*)(lds + EPI_LDS) + 2048};
#ifndef NO_G7
          gemm_phase<EpiFFN, StaticOrder, true, true>(lds, g, S, E);
#endif
        }
        GRID_SYNC();
        { PHASE_PTRS(); Gemm g{HB, (const bf16_t*)(wb + W_D), T, 1024, 2816}; StaticOrder S; S.init(T, 1024, G, bid);
          EpiRes E{xout, xout, XB, ss1n, l + 1 == DEPTH};
#ifndef NO_G8
          gemm_phase<EpiRes, StaticOrder, true, true>(lds, g, S, E);
#endif
        }
        if (l0 + 1 < DEPTH) GRID_SYNC();
    }
}

extern "C" void kernel_launch(void* const* d_in, const int* in_sizes, int n_in, void* d_out, int out_size, void* d_ws, size_t ws_size, hipStream_t stream) {
    static int grid = 0;
    if (grid == 0) {
        if (n_in != 16 || out_size != T * 1024 || ws_size < WS_END) { fprintf(stderr, "kernel_launch: unexpected shapes (n_in %d, out %d, ws %zu)\n", n_in, out_size, ws_size); grid = -1; return; }
        int dev = 0, cus = 0, per_cu = 0;
        hipGetDevice(&dev); hipDeviceGetAttribute(&cus, hipDeviceAttributeMultiprocessorCount, dev);
        hipFuncSetAttribute((const void*)hybrid_fwd, hipFuncAttributeMaxDynamicSharedMemorySize, LDS_BYTES);
        hipOccupancyMaxActiveBlocksPerMultiprocessor(&per_cu, (const void*)hybrid_fwd, 512, LDS_BYTES);
        if (per_cu < 1) per_cu = 1;
        (void)hipGetLastError();
        grid = cus * per_cu;
    }
    if (grid < 0) return;
    Args a{};
    for (int i = 0; i < 16; ++i) a.in[i] = (const float*)d_in[i];
    a.out = (float*)d_out; a.ws = (unsigned char*)d_ws;
    void* args[] = {&a};
    hipError_t e = hipLaunchCooperativeKernel((const void*)hybrid_fwd, dim3(grid), dim3(512), args, LDS_BYTES, stream);
    if (e != hipSuccess) fprintf(stderr, "cooperative launch failed: %s (grid %d)\n", hipGetErrorString(e), grid);
}
```

```cpp
#include <hip/hip_runtime.h>
#include <hip/hip_cooperative_groups.h>
#include <cstdio>
#include <cstdint>
namespace cg = cooperative_groups;

namespace pg8 {
#define PG8_LAS __attribute__((address_space(3)))
typedef unsigned short bf16_t;
typedef short bf16x8 __attribute__((ext_vector_type(8)));
typedef float f32x4 __attribute__((ext_vector_type(4)));
typedef unsigned u32x4 __attribute__((ext_vector_type(4)));
constexpr int BM = 256, BK = 64, HALF = 128, HTB = HALF * BK * 2  , STAGE_BYTES = 8 * HTB, NXCD = 8, WGM = 8;

__host__ __device__ __forceinline__ int lds_byte(int r, int c) { const int st = (r >> 4) * 2 + (c >> 5), rr = r & 15, cc = c & 31, ob = rr * 64 + cc * 2; return st * 1024 + (ob ^ (((ob >> 9) & 1) << 5)); }
__host__ __device__ __forceinline__ void stage_rc(int b, int& R, int& C) { const int st = b / 1024, sb = b % 1024, swz = sb ^ (((sb >> 9) & 1) << 5); R = (st >> 1) * 16 + swz / 64; C = (st & 1) * 32 + (swz % 64) / 2; }
__host__ __device__ __forceinline__ int perm32(int rho) { const int n = rho >> 4, i = rho & 15; return 8 * (i >> 2) + 4 * n + (i & 3); }

struct Unit { int pm, pn; };
struct Gemm { const bf16_t* A; const bf16_t* Bt; int M, N, K; };

struct StaticOrder {
    int nM, nN, nwg, G, c;
    __host__ __device__ void init(int M, int N, int G_, int c_) { nM = M / BM; nN = N / BM; nwg = nM * nN; G = G_; c = c_; }
    __host__ __device__ bool next(int i, Unit& u) const {
        const long L = (long)i * G + c; if (L >= nwg) return false;
        int wgid = (int)L; { const int q = nwg / NXCD, r = nwg % NXCD, xcd = wgid % NXCD, off = wgid / NXCD; wgid = (xcd < r ? xcd * (q + 1) : r * (q + 1) + (xcd - r) * q) + off; }
        const int nig = WGM * nN, gid = wgid / nig, fm = gid * WGM, gsz = (nM - fm) < WGM ? (nM - fm) : WGM;
        u.pm = fm + ((wgid % nig) % gsz); u.pn = (wgid % nig) / gsz; return true;
    }
    __device__ __forceinline__ void a_ready(const Unit&) const {}
    __device__ __forceinline__ void done(const Unit&) const {}
};

typedef unsigned u32x2 __attribute__((ext_vector_type(2)));
typedef float f32x2 __attribute__((ext_vector_type(2)));
typedef __bf16 bf16x2_t __attribute__((ext_vector_type(2)));
constexpr float EPS_ = 1e-6f;
constexpr int T_ = 32768;
__device__ __forceinline__ unsigned pk2(float lo, float hi) { f32x2 v = {lo, hi}; bf16x2_t b = __builtin_convertvector(v, bf16x2_t); return __builtin_bit_cast(unsigned, b); }
__device__ __forceinline__ u32x4 pk8(f32x4 a, f32x4 b) { u32x4 w; w.x = pk2(a[0], a[1]); w.y = pk2(a[2], a[3]); w.z = pk2(b[0], b[1]); w.w = pk2(b[2], b[3]); return w; }
__device__ __forceinline__ float bflo(unsigned w) { return __uint_as_float(w << 16); }
__device__ __forceinline__ float bfhi(unsigned w) { return __uint_as_float(w & 0xffff0000u); }
__device__ __forceinline__ void unpk8(u32x4 w, f32x4& a, f32x4& b) { a = (f32x4){bflo(w.x), bfhi(w.x), bflo(w.y), bfhi(w.y)}; b = (f32x4){bflo(w.z), bfhi(w.z), bflo(w.w), bfhi(w.w)}; }
__device__ __forceinline__ float sigm(float x) { return __builtin_amdgcn_rcpf(1.f + __expf(-x)); }
__device__ __forceinline__ f32x4 sigm4(f32x4 v) { return (f32x4){sigm(v[0]), sigm(v[1]), sigm(v[2]), sigm(v[3])}; }
__device__ __forceinline__ f32x4 silu4(f32x4 v) { return v * sigm4(v); }
__device__ __forceinline__ float rowscale(const float* rowss, int row) { const f32x4* p = (const f32x4*)(rowss + (size_t)row * 16); const f32x4 a = p[0], b = p[1], c = p[2], d = p[3];
    const float s = (((a[0] + a[1]) + (a[2] + a[3])) + ((b[0] + b[1]) + (b[2] + b[3]))) + (((c[0] + c[1]) + (c[2] + c[3])) + ((d[0] + d[1]) + (d[2] + d[3])));
    return rsqrtf(s * (1.f / 1024.f) + EPS_); }
__device__ __forceinline__ void stage_rowscale(PG8_LAS float* RS, const float* rowss, int pm) {
    int t = threadIdx.x; asm volatile("" : "+v"(t));
    if (t < 256) RS[t] = rowscale(rowss, pm * 256 + t);
    asm volatile("s_waitcnt lgkmcnt(0)" ::: "memory"); __builtin_amdgcn_s_barrier(); asm volatile("" ::: "memory");
}
#define EPI_ROWS(ai, m) _Pragma("unroll") for (int ai = 0; ai < 2; ++ai) _Pragma("unroll") for (int m = 0; m < 4; ++m)
#define EPI_FENCE(m) do { if ((m) & 1) asm volatile("" ::: "memory"); } while (0)

struct EpiInA {
    static constexpr bool PERM = true, AFTER_DRAIN = false;
    bf16_t* out; const float* rowss; const float* qn; const float* kn; const float* rope; PG8_LAS float* P; float qscale;
    __device__ __forceinline__ void operator()(const f32x4 (&acc)[2][2][4][2], const Unit& u, int wr, int wc, int fr, int fq) const {
        int rl0 = wr * 64 + fr; asm volatile("" : "+v"(rl0)); const int col0 = u.pn * 256 + wc * 32 + 8 * fq;
        stage_rowscale(P + 2048, rowss, u.pm);
        if (u.pn < 8) {
            EPI_ROWS(ai, m) { const int rl = ai * 128 + rl0 + m * 16; const float rs = P[2048 + rl];
#pragma unroll
                for (int bj = 0; bj < 2; ++bj) { const f32x4 a = acc[ai][bj][m][0] * rs, b = acc[ai][bj][m][1] * rs;
                    float ss = (a[0] * a[0] + a[1] * a[1]) + (a[2] * a[2] + a[3] * a[3]) + (b[0] * b[0] + b[1] * b[1]) + (b[2] * b[2] + b[3] * b[3]);
                    ss += __shfl_xor(ss, 16); ss += __shfl_xor(ss, 32);
                    if (fq == 0) P[rl * 8 + bj * 4 + wc] = ss; }
                EPI_FENCE(m); }
            asm volatile("s_waitcnt lgkmcnt(0)" ::: "memory"); __builtin_amdgcn_s_barrier(); asm volatile("" ::: "memory");
            const float* gp = (u.pn < 6) ? qn : kn; const float sc = (u.pn < 6) ? qscale : 1.f;
            const f32x4 g0 = *(const f32x4*)(gp + 16 * wc + 4 * fq) * sc, g1 = *(const f32x4*)(gp + 64 + 16 * wc + 4 * fq) * sc;
            EPI_ROWS(ai, m) { const int rl = ai * 128 + rl0 + m * 16; const int row = u.pm * 256 + rl; const float rs = P[2048 + rl];
                const u32x4 cw = *(const u32x4*)((const unsigned*)rope + (size_t)row * 64 + 16 * wc + 4 * fq);
#define H2F_LO(w_) ((float)__builtin_bit_cast(_Float16, (unsigned short)((w_) & 0xffffu)))
#define H2F_HI(w_) ((float)__builtin_bit_cast(_Float16, (unsigned short)((w_) >> 16)))
                const f32x4 cs = {H2F_LO(cw[0]), H2F_LO(cw[1]), H2F_LO(cw[2]), H2F_LO(cw[3])}, sn = {H2F_HI(cw[0]), H2F_HI(cw[1]), H2F_HI(cw[2]), H2F_HI(cw[3])};
#pragma unroll
                for (int bj = 0; bj < 2; ++bj) { const f32x4 pp = *(const PG8_LAS f32x4*)(P + rl * 8 + bj * 4);
                    const float hn = rsqrtf(((pp[0] + pp[1]) + (pp[2] + pp[3])) * (1.f / 128.f) + EPS_) * rs;
                    const f32x4 x1 = acc[ai][bj][m][0] * hn * g0, x2 = acc[ai][bj][m][1] * hn * g1;
                    const f32x4 o1 = x1 * cs - x2 * sn, o2 = x2 * cs + x1 * sn;
                    *(u32x4*)(out + (size_t)row * 2560 + col0 + bj * 128) = pk8(o1, o2); } asm volatile("" ::: "memory"); }
        } else {
            EPI_ROWS(ai, m) { const int rl = ai * 128 + rl0 + m * 16; const int row = u.pm * 256 + rl; const float rs = P[2048 + rl];
#pragma unroll
                for (int bj = 0; bj < 2; ++bj) *(u32x4*)(out + (size_t)row * 2560 + col0 + bj * 128) = pk8(acc[ai][bj][m][0] * rs, acc[ai][bj][m][1] * rs); EPI_FENCE(m); }
        }
    }
};
struct EpiInB {
    static constexpr bool PERM = true, AFTER_DRAIN = false;
    bf16_t* out; bf16_t* rb; float* ab; const float* rowss; PG8_LAS float* RS;
    __device__ __forceinline__ void operator()(const f32x4 (&acc)[2][2][4][2], const Unit& u, int wr, int wc, int fr, int fq) const {
        int rl0 = wr * 64 + fr; asm volatile("" : "+v"(rl0)); const int cin = wc * 32 + 8 * fq;
        stage_rowscale(RS, rowss, u.pm);
        EPI_ROWS(ai, m) { const int rl = ai * 128 + rl0 + m * 16; const int row = u.pm * 256 + rl; float rs = RS[rl];
            if (u.pn < 8) { if (u.pn < 2) rs *= 0.08838834764831845f;
#pragma unroll
                for (int bj = 0; bj < 2; ++bj) *(u32x4*)(out + (size_t)row * 2048 + u.pn * 256 + cin + bj * 128) = pk8(acc[ai][bj][m][0] * rs, acc[ai][bj][m][1] * rs);
            } else if (u.pn < 12) {
#pragma unroll
                for (int bj = 0; bj < 2; ++bj) *(u32x4*)(rb + (size_t)row * 1024 + (u.pn - 8) * 256 + cin + bj * 128) = pk8(silu4(acc[ai][bj][m][0] * rs), silu4(acc[ai][bj][m][1] * rs));
            } else if (wc == 0 && fq < 2) {
                *(f32x4*)(ab + (size_t)row * 16 + 8 * fq) = acc[ai][0][m][0] * rs; *(f32x4*)(ab + (size_t)row * 16 + 8 * fq + 4) = acc[ai][0][m][1] * rs;
            } EPI_FENCE(m); }
    }
};
struct EpiInC {
    static constexpr bool PERM = true, AFTER_DRAIN = false;
    bf16_t* ga; bf16_t* gb; const float* rowss; PG8_LAS float* RS;
    __device__ __forceinline__ void operator()(const f32x4 (&acc)[2][2][4][2], const Unit& u, int wr, int wc, int fr, int fq) const {
        int rl0 = wr * 64 + fr; asm volatile("" : "+v"(rl0)); bf16_t* base = (u.pn < 4) ? ga : gb; const int col0 = (u.pn & 3) * 256 + wc * 32 + 8 * fq;
        stage_rowscale(RS, rowss, u.pm);
        EPI_ROWS(ai, m) { const int rl = ai * 128 + rl0 + m * 16; const int row = u.pm * 256 + rl; const float rs = RS[rl];
#pragma unroll
            for (int bj = 0; bj < 2; ++bj) *(u32x4*)(base + (size_t)row * 1024 + col0 + bj * 128) = pk8(sigm4(acc[ai][bj][m][0] * rs), sigm4(acc[ai][bj][m][1] * rs)); EPI_FENCE(m); }
    }
};
template <int MODE> struct EpiProj {
    static constexpr bool PERM = true, AFTER_DRAIN = false;
    bf16_t* y; const bf16_t* gb;
    __device__ __forceinline__ void operator()(const f32x4 (&acc)[2][2][4][2], const Unit& u, int wr, int wc, int fr, int fq) const {
        int rl0 = wr * 64 + fr; asm volatile("" : "+v"(rl0)); const int col0 = u.pn * 256 + wc * 32 + 8 * fq;
        EPI_ROWS(ai, m) { const int row = u.pm * 256 + ai * 128 + rl0 + m * 16;
#pragma unroll
            for (int bj = 0; bj < 2; ++bj) { const size_t off = (size_t)row * 1024 + col0 + bj * 128; f32x4 a, b; unpk8(*(const u32x4*)(y + off), a, b);
                if (MODE == 0) { a = a * acc[ai][bj][m][0]; b = b * acc[ai][bj][m][1]; }
                else { f32x4 c, d; unpk8(*(const u32x4*)(gb + off), c, d); a = a + c * acc[ai][bj][m][0]; b = b + d * acc[ai][bj][m][1]; }
                *(u32x4*)(y + off) = pk8(a, b); } EPI_FENCE(m); }
    }
};
struct EpiRes {
    static constexpr bool PERM = true, AFTER_DRAIN = false;
    const float* xin; float* xout; bf16_t* xb; float* ssout; int last;
    __device__ __forceinline__ void operator()(const f32x4 (&acc)[2][2][4][2], const Unit& u, int wr, int wc, int fr, int fq) const {
        int rl0 = wr * 64 + fr; asm volatile("" : "+v"(rl0)); const int col0 = u.pn * 256 + wc * 32 + 8 * fq;
        EPI_ROWS(ai, m) { const int row = u.pm * 256 + ai * 128 + rl0 + m * 16; float ss = 0.f;
#pragma unroll
            for (int bj = 0; bj < 2; ++bj) { const size_t off = (size_t)row * 1024 + col0 + bj * 128;
                const f32x4 a = *(const f32x4*)(xin + off) + acc[ai][bj][m][0], b = *(const f32x4*)(xin + off + 4) + acc[ai][bj][m][1];
                *(f32x4*)(xout + off) = a; *(f32x4*)(xout + off + 4) = b; if (!last) *(u32x4*)(xb + off) = pk8(a, b);
                ss += (a[0] * a[0] + a[1] * a[1]) + (a[2] * a[2] + a[3] * a[3]) + (b[0] * b[0] + b[1] * b[1]) + (b[2] * b[2] + b[3] * b[3]); }
            ss += __shfl_xor(ss, 16); ss += __shfl_xor(ss, 32);
            if (fq == 0 && !last) ssout[(size_t)row * 16 + u.pn * 4 + wc] = ss; EPI_FENCE(m); }
    }
};
struct EpiFFN {
    static constexpr bool PERM = true, AFTER_DRAIN = false;
    bf16_t* hb; const float* rowss; PG8_LAS float* RS;
    __device__ __forceinline__ void operator()(const f32x4 (&acc)[2][2][4][2], const Unit& u, int wr, int wc, int fr, int fq) const {
        int rl0 = wr * 64 + fr; asm volatile("" : "+v"(rl0)); const int col0 = u.pn * 128 + wc * 32 + 8 * fq;
        stage_rowscale(RS, rowss, u.pm);
        EPI_ROWS(ai, m) { const int rl = ai * 128 + rl0 + m * 16; const int row = u.pm * 256 + rl; const float rs = RS[rl];
            const f32x4 a = silu4(acc[ai][0][m][0] * rs) * (acc[ai][1][m][0] * rs), b = silu4(acc[ai][0][m][1] * rs) * (acc[ai][1][m][1] * rs);
            *(u32x4*)(hb + (size_t)row * 2816 + col0) = pk8(a, b); EPI_FENCE(m); }
    }
};
template <class Epi, class Sched, bool ALIGN_EPI = false, bool SP2 = false>
__device__ __forceinline__ void gemm_phase(PG8_LAS unsigned char* lds, const Gemm g, const Sched& S, const Epi& E) {
    int tid_raw = threadIdx.x; asm volatile("" : "+v"(tid_raw));
    const int tid = tid_raw, wid = __builtin_amdgcn_readfirstlane(tid >> 6), lane = tid & 63, wr = wid >> 2, wc = wid & 3, fr = lane & 15, fq = lane >> 4;
    const int K = g.K, nt = K / BK;
    unsigned voffA[2], voffB[2];
#pragma unroll
    for (int i = 0; i < 2; ++i) { int R, C; stage_rc(tid * 16 + i * 8192, R, C); const int Rb = Epi::PERM ? ((R & ~31) + perm32(R & 31)) : R;
        voffA[i] = (unsigned)(R * K + C) * 2u; voffB[i] = (unsigned)(Rb * K + C) * 2u; }
    const size_t kstep = (size_t)(BK * 2);
    const size_t hstep = (size_t)HALF * K * 2;
    const size_t tstep = 2 * hstep;
    const unsigned ldsw = (unsigned)wid * 1024u;
    const int aoff = lds_byte(wr * 64 + fr, fq * 8), boff = lds_byte(wc * 32 + fr, fq * 8);
#define PG8_SA(b, h) (((b) * 2 + (h)) * HTB)
#define PG8_SB(b, h) ((4 + (b) * 2 + (h)) * HTB)
#define PG8_STAGE(bufoff, gbase, voff) do { _Pragma("unroll") for (int _i = 0; _i < 2; ++_i) \
        __builtin_amdgcn_global_load_lds((const unsigned*)((const char*)(gbase) + (voff)[_i]), (PG8_LAS unsigned*)(lds + (bufoff) + ldsw + _i * 8192), 16, 0, 0); } while (0)
#define PG8_LDA(dst, b, h) do { _Pragma("unroll") for (int m = 0; m < 4; ++m) _Pragma("unroll") for (int k = 0; k < 2; ++k) dst[m][k] = *(const PG8_LAS bf16x8*)(lds + PG8_SA(b, h) + aoff + m * 2048 + k * 1024); } while (0)
#define PG8_LDB(dst, b, h) do { _Pragma("unroll") for (int n = 0; n < 2; ++n) _Pragma("unroll") for (int k = 0; k < 2; ++k) dst[n][k] = *(const PG8_LAS bf16x8*)(lds + PG8_SB(b, h) + boff + n * 2048 + k * 1024); } while (0)
#define PG8_MMA(ai, bj, At, Bt) do { __builtin_amdgcn_s_setprio(1); _Pragma("unroll") for (int m = 0; m < 4; ++m) _Pragma("unroll") for (int n = 0; n < 2; ++n) _Pragma("unroll") for (int k = 0; k < 2; ++k) \
        acc[ai][bj][m][n] = __builtin_amdgcn_mfma_f32_16x16x32_bf16(Bt[n][k], At[m][k], acc[ai][bj][m][n], 0, 0, 0); __builtin_amdgcn_s_setprio(0); } while (0)
#define PG8_WAIT_V(n) asm volatile("s_waitcnt vmcnt(" #n ")" ::: "memory")
#define PG8_WAIT_L(n) asm volatile("s_waitcnt lgkmcnt(" #n ")" ::: "memory")
#define PG8_BAR __builtin_amdgcn_s_barrier()
#define PG8_SCHED __builtin_amdgcn_sched_barrier(0)
    Unit cur, nxt; int ui = 0;
    if (!S.next(0, cur)) return;
    f32x4 acc[2][2][4][2];
#pragma unroll
    for (int a = 0; a < 2; ++a)
#pragma unroll
        for (int b = 0; b < 2; ++b)
#pragma unroll
            for (int m = 0; m < 4; ++m)
#pragma unroll
                for (int n = 0; n < 2; ++n) acc[a][b][m][n] = (f32x4){0.f, 0.f, 0.f, 0.f};
    bf16x8 At[4][2], B0[2][2], B1[2][2];
    const char* cA = (const char*)g.A + (size_t)cur.pm * tstep; const char* cB = (const char*)g.Bt + (size_t)cur.pn * tstep;
    S.a_ready(cur);
    if constexpr (SP2) {
        PG8_STAGE(PG8_SB(0, 0), cB, voffB); PG8_STAGE(PG8_SB(0, 1), cB + hstep, voffB); PG8_STAGE(PG8_SA(0, 0), cA, voffA); PG8_STAGE(PG8_SA(0, 1), cA + hstep, voffA);
        if (wr == 1) PG8_BAR;
        PG8_WAIT_V(2); PG8_BAR;
        PG8_STAGE(PG8_SB(1, 0), cB + kstep, voffB); PG8_STAGE(PG8_SA(1, 0), cA + kstep, voffA); PG8_STAGE(PG8_SB(1, 1), cB + hstep + kstep, voffB);
        PG8_WAIT_V(6); PG8_BAR;
    } else {
        PG8_STAGE(PG8_SB(0, 0), cB, voffB); PG8_STAGE(PG8_SA(0, 0), cA, voffA); PG8_STAGE(PG8_SB(0, 1), cB + hstep, voffB); PG8_STAGE(PG8_SA(0, 1), cA + hstep, voffA);
        if (wr == 1) PG8_BAR;
        PG8_WAIT_V(4); PG8_BAR;
        PG8_STAGE(PG8_SB(1, 0), cB + kstep, voffB); PG8_STAGE(PG8_SA(1, 0), cA + kstep, voffA); PG8_STAGE(PG8_SB(1, 1), cB + hstep + kstep, voffB);
        PG8_WAIT_V(6); PG8_BAR;
    }
    for (;;) {
        const bool has_next = S.next(ui + 1, nxt);
        const char* nA = has_next ? (const char*)g.A + (size_t)nxt.pm * tstep : cA; const char* nB = has_next ? (const char*)g.Bt + (size_t)nxt.pn * tstep : cB;
        for (int t = 0; t < nt; t += 2) {
            const bool last = (t == nt - 2);
            const char* a1 = cA + (size_t)(t + 1) * kstep;
            const char* a2 = last ? nA : cA + (size_t)(t + 2) * kstep; const char* b2 = last ? nB : cB + (size_t)(t + 2) * kstep;
            const char* a3 = a2 + kstep; const char* b3 = b2 + kstep;
            if (last && has_next) S.a_ready(nxt);
            if constexpr (SP2) {
            PG8_LDB(B0, 0, 0); PG8_LDB(B1, 0, 1); PG8_SCHED; PG8_LDA(At, 0, 0); PG8_STAGE(PG8_SA(1, 1), a1 + hstep, voffA);
            PG8_WAIT_V(8); PG8_WAIT_L(0); PG8_BAR; PG8_MMA(0, 0, At, B0); PG8_MMA(0, 1, At, B1); PG8_BAR; PG8_SCHED;
            PG8_LDA(At, 0, 1); PG8_STAGE(PG8_SB(0, 0), b2, voffB); PG8_STAGE(PG8_SB(0, 1), b2 + hstep, voffB); PG8_STAGE(PG8_SA(0, 0), a2, voffA);
            PG8_WAIT_V(8); PG8_WAIT_L(0); PG8_BAR; PG8_MMA(1, 0, At, B0); PG8_MMA(1, 1, At, B1); PG8_BAR; PG8_SCHED;
            PG8_LDB(B0, 1, 0); PG8_LDB(B1, 1, 1); PG8_SCHED; PG8_LDA(At, 1, 0); PG8_STAGE(PG8_SA(0, 1), a2 + hstep, voffA);
            PG8_WAIT_V(8); PG8_WAIT_L(0); PG8_BAR; PG8_MMA(0, 0, At, B0); PG8_MMA(0, 1, At, B1); PG8_BAR; PG8_SCHED;
            PG8_LDA(At, 1, 1); PG8_STAGE(PG8_SB(1, 0), b3, voffB); PG8_STAGE(PG8_SB(1, 1), b3 + hstep, voffB); PG8_STAGE(PG8_SA(1, 0), a3, voffA);
            PG8_WAIT_V(8); PG8_WAIT_L(0); PG8_BAR; PG8_MMA(1, 0, At, B0); PG8_MMA(1, 1, At, B1); PG8_BAR; PG8_SCHED;
            } else {
            PG8_LDB(B0, 0, 0); PG8_SCHED; PG8_LDA(At, 0, 0); PG8_STAGE(PG8_SA(1, 1), a1 + hstep, voffA);
            PG8_WAIT_L(8); PG8_BAR; PG8_WAIT_L(0); PG8_MMA(0, 0, At, B0); PG8_BAR; PG8_SCHED;
            PG8_LDB(B1, 0, 1); PG8_STAGE(PG8_SB(0, 0), b2, voffB);
            PG8_BAR; PG8_WAIT_L(0); PG8_MMA(0, 1, At, B1); PG8_BAR;
            PG8_LDA(At, 0, 1); PG8_STAGE(PG8_SA(0, 0), a2, voffA);
            PG8_BAR; PG8_WAIT_L(0); PG8_MMA(1, 0, At, B0); PG8_BAR; PG8_SCHED;
            PG8_STAGE(PG8_SB(0, 1), b2 + hstep, voffB);
            PG8_WAIT_V(6); PG8_BAR; PG8_MMA(1, 1, At, B1); PG8_BAR;
            PG8_LDB(B0, 1, 0); PG8_SCHED; PG8_LDA(At, 1, 0); PG8_STAGE(PG8_SA(0, 1), a2 + hstep, voffA);
            PG8_WAIT_L(8); PG8_BAR; PG8_WAIT_L(0); PG8_MMA(0, 0, At, B0); PG8_BAR; PG8_SCHED;
            PG8_LDB(B1, 1, 1); PG8_STAGE(PG8_SB(1, 0), b3, voffB);
            PG8_BAR; PG8_WAIT_L(0); PG8_MMA(0, 1, At, B1); PG8_BAR;
            PG8_LDA(At, 1, 1); PG8_STAGE(PG8_SA(1, 0), a3, voffA);
            PG8_BAR; PG8_WAIT_L(0); PG8_MMA(1, 0, At, B0); PG8_BAR; PG8_SCHED;
            PG8_STAGE(PG8_SB(1, 1), b3 + hstep, voffB);
            PG8_WAIT_V(6); PG8_BAR; PG8_MMA(1, 1, At, B1); PG8_BAR;
            }
        }
        if constexpr (ALIGN_EPI) { if (wr == 0) PG8_BAR; }
        if constexpr (!Epi::AFTER_DRAIN) { E(acc, cur, wr, wc, fr, fq); S.done(cur); }
        if (!has_next) break;
#pragma unroll
        for (int a = 0; a < 2; ++a)
#pragma unroll
            for (int b = 0; b < 2; ++b)
#pragma unroll
                for (int m = 0; m < 4; ++m)
#pragma unroll
                    for (int n = 0; n < 2; ++n) acc[a][b][m][n] = (f32x4){0.f, 0.f, 0.f, 0.f};
        cur = nxt; cA = nA; cB = nB; ++ui;
        if constexpr (ALIGN_EPI) { if (wr == 1) PG8_BAR; }
    }
    PG8_WAIT_V(0);
    if constexpr (!ALIGN_EPI) { if (wr == 0) PG8_BAR; }
    PG8_BAR;
    if constexpr (Epi::AFTER_DRAIN) { E.fused(acc, cur, wr, wc, fr, fq, lds, wid, lane); S.done(cur); }
#undef PG8_SA
#undef PG8_SB
#undef PG8_STAGE
#undef PG8_LDA
#undef PG8_LDB
#undef PG8_MMA
#undef PG8_WAIT_V
#undef PG8_WAIT_L
#undef PG8_BAR
#undef PG8_SCHED
}
}
using namespace pg8;
#define LAS __attribute__((address_space(3)))
#define DI __device__ __forceinline__
typedef short s16x4 __attribute__((ext_vector_type(4)));
typedef short v4i16_t __attribute__((ext_vector_type(4)));
typedef float f32x16 __attribute__((ext_vector_type(16)));
constexpr int T = 32768, SEQ = 2048, DEPTH = 4;
constexpr float EPS = 1e-6f;
constexpr float QSCALE = 0.08838834764831845f * 1.4426950408889634f;
constexpr size_t MiB = 1u << 20, HM = 1u << 19;
constexpr size_t W_LAYER = 37 * MiB;
constexpr size_t W_INA = 0, W_INB = 5 * MiB, W_INC = 11 * MiB + HM, W_PA = 15 * MiB + HM, W_PB = 16 * MiB + HM, W_OUT = 18 * MiB + HM, W_GU = 20 * MiB + HM, W_D = 31 * MiB + HM;
constexpr size_t WS_XB = 74 * MiB, WS_R = 138 * MiB;
constexpr size_t R_OG = 0, R_BUFA = 96 * MiB, R_BUFB = 96 * MiB, R_RB = 224 * MiB, R_GA = 32 * MiB, R_GB = 96 * MiB, R_HB = 96 * MiB;
constexpr size_t WS_ROPE = 426 * MiB, WS_AB = 434 * MiB, WS_DEN = 436 * MiB, WS_ROWSS = 438 * MiB, WS_BLG = 442 * MiB, WS_BAR = 443 * MiB, WS_GB = 444 * MiB, WS_END = 508 * MiB;
constexpr int LDS_BYTES = 147456, EPI_LDS = 131072;
struct Args { const float* in[16]; float* out; unsigned char* ws; };

#define MFMA32(a, b, c) __builtin_amdgcn_mfma_f32_32x32x16_bf16((a), (b), (c), 0, 0, 0)
DI int crow(int reg, int h) { return (reg & 3) + 8 * (reg >> 2) + 4 * h; }
DI bf16x8 pack8(const f32x16& x, int s) { u32x4 p; p.x = pk2(x[8 * s], x[8 * s + 1]); p.y = pk2(x[8 * s + 2], x[8 * s + 3]); p.z = pk2(x[8 * s + 4], x[8 * s + 5]); p.w = pk2(x[8 * s + 6], x[8 * s + 7]); return __builtin_bit_cast(bf16x8, p); }
DI s16x4 vtr(const LAS unsigned char* p) { return __builtin_bit_cast(s16x4, __builtin_amdgcn_ds_read_tr16_b64_v4i16((LAS v4i16_t*)p)); }
DI bf16x8 cat8(s16x4 lo, s16x4 hi) { return __builtin_shufflevector(lo, hi, 0, 1, 2, 3, 4, 5, 6, 7); }
DI f32x16 zero16() { float z = 0.f; asm volatile("" : "+v"(z)); f32x16 r;
#pragma unroll
    for (int i = 0; i < 16; ++i) r[i] = z;
    return r; }
DI float wave_sum(float v) {
#pragma unroll
    for (int o = 1; o < 64; o <<= 1) v += __shfl_xor(v, o);
    return v;
}

DI void conv_tile(const float* src, int ldw, int K, int col, const float* ksc, bf16_t* WT, int p0, int k0, LAS float* scr, int lane) {
#pragma unroll 16
    for (int i = 0; i < 32; ++i) { const int kk = 2 * i + (lane >> 5); float v = 0.f;
        if (col >= 0) { v = src[(size_t)(k0 + kk) * ldw + col]; if (ksc) v *= ksc[k0 + kk]; }
        scr[kk * 33 + (lane & 31)] = v; }
    asm volatile("s_waitcnt lgkmcnt(0)" ::: "memory");
    const int c = lane & 7;
#pragma unroll
    for (int j = 0; j < 4; ++j) { const int n = (lane >> 3) + 8 * j; const LAS float* s = scr + (8 * c) * 33 + n;
        u32x4 o; o.x = pk2(s[0 * 33], s[1 * 33]); o.y = pk2(s[2 * 33], s[3 * 33]); o.z = pk2(s[4 * 33], s[5 * 33]); o.w = pk2(s[6 * 33], s[7 * 33]);
        *(u32x4*)(WT + (size_t)(p0 + n) * K + k0 + 8 * c) = o; }
    asm volatile("s_waitcnt lgkmcnt(0)" ::: "memory");
}
constexpr int CONV_ITEMS = 1280 + 1664 + 1024 + 256 + 512 + 512 + 2816 + 1408;
DI void conv_layer(const Args& a, int l, unsigned char* wbytes, LAS float* scr, int gw, int ngw) {
    int lane = threadIdx.x; asm volatile("" : "+v"(lane)); lane &= 63;
    const float* win = a.in[3] + (size_t)l * 1024 * 7696; const float* n1 = a.in[2] + l * 1024; const float* n2 = a.in[12] + l * 1024;
    const int pl = lane & 31;
    for (int it = gw; it < CONV_ITEMS; it += ngw) {
        int r = it;
        if (r < 1280) { const int nb = r % 80, kb = r / 80, p = 32 * nb + pl; int col = p;
            if (p < 2048) { const int w = p & 127, j = w >> 3, e = w & 7; col = (p & ~127) + (e < 4 ? 4 * j + e : 64 + 4 * j + e - 4); }
            conv_tile(win, 7696, 1024, col, n1, (bf16_t*)(wbytes + W_INA), 32 * nb, 64 * kb, scr, lane); continue; }
        r -= 1280;
        if (r < 1664) { const int nb = r % 104, kb = r / 104, p = 32 * nb + pl; const int col = p < 3072 ? 2560 + p : (p < 3088 ? 5632 + (p - 3072) : -1);
            conv_tile(win, 7696, 1024, col, n1, (bf16_t*)(wbytes + W_INB), 32 * nb, 64 * kb, scr, lane); continue; }
        r -= 1664;
        if (r < 1024) { const int nb = r % 64, kb = r / 64, p = 32 * nb + pl;
            conv_tile(win, 7696, 1024, 5648 + p, n1, (bf16_t*)(wbytes + W_INC), 32 * nb, 64 * kb, scr, lane); continue; }
        r -= 1024;
        if (r < 256) { const int nb = r % 32, kb = r / 32;
            conv_tile(a.in[9] + (size_t)l * 512 * 1024, 1024, 512, 32 * nb + pl, nullptr, (bf16_t*)(wbytes + W_PA), 32 * nb, 64 * kb, scr, lane); continue; }
        r -= 256;
        if (r < 512) { const int nb = r % 32, kb = r / 32;
            conv_tile(a.in[10] + (size_t)l * 1024 * 1024, 1024, 1024, 32 * nb + pl, nullptr, (bf16_t*)(wbytes + W_PB), 32 * nb, 64 * kb, scr, lane); continue; }
        r -= 512;
        if (r < 512) { const int nb = r % 32, kb = r / 32;
            conv_tile(a.in[11] + (size_t)l * 1024 * 1024, 1024, 1024, 32 * nb + pl, nullptr, (bf16_t*)(wbytes + W_OUT), 32 * nb, 64 * kb, scr, lane); continue; }
        r -= 512;
        if (r < 2816) { const int nb = r % 176, kb = r / 176, p = 32 * nb + pl, t = p >> 8, c = p & 255;
            const float* src = (c < 128 ? a.in[13] : a.in[14]) + (size_t)l * 1024 * 2816;
            conv_tile(src, 2816, 1024, 128 * t + (c & 127), n2, (bf16_t*)(wbytes + W_GU), 32 * nb, 64 * kb, scr, lane); continue; }
        r -= 2816;
        { const int nb = r % 32, kb = r / 32;
            conv_tile(a.in[15] + (size_t)l * 2816 * 1024, 1024, 2816, 32 * nb + pl, nullptr, (bf16_t*)(wbytes + W_D), 32 * nb, 64 * kb, scr, lane); }
    }
}

struct AttnU { int b, h, g, d, r, nb, jstart; };
DI AttnU attn_decode(int idx) { AttnU u; const int rem = idx % 192, uu = rem & 15; u.b = idx / 192; u.h = rem / 48; u.g = (rem % 48) >> 4; const int sh = 2 * u.g; u.d = 1 << sh; u.r = uu & (u.d - 1); u.nb = uu >> sh; u.jstart = (u.nb == 0) ? 128 : 0; return u; }
DI void attn_phase(LAS unsigned char* lds, const bf16_t* bufA, bf16_t* OG, float* DEN, int bid, int G) {
    int tid_raw = threadIdx.x; asm volatile("" : "+v"(tid_raw));
    const int tid = tid_raw, lane = tid & 63, w = __builtin_amdgcn_readfirstlane(tid >> 6), l31 = lane & 31, h2 = lane >> 5;
    const int qt = w >> 1, dbase = 2 * (w & 1), q4 = (lane & 15) >> 2, p4 = lane & 3, blk = (lane >> 4) & 1;
    LAS unsigned char* Ks = lds; LAS unsigned char* Vs = lds + 65536;
    const int per = (3072 + G - 1) / G, u0 = bid * per, u1 = (u0 + per < 3072) ? u0 + per : 3072;
    u32x4 kreg[8], vreg[8];
#define ATTN_ISSUE(U) do { _Pragma("unroll") for (int it = 0; it < 8; ++it) { const int e = tid + 512 * it, j = e >> 4, ch = e & 15; \
        if (j >= (U).jstart) { const int tk = (((U).nb - 1) * 128 + j) * (U).d + (U).r; const bf16_t* src = bufA + ((size_t)(U).b * SEQ + tk) * 2560 + (U).h * 128 + ch * 8; \
            kreg[it] = *(const u32x4*)(src + 1536); vreg[it] = *(const u32x4*)(src + 2048); } } } while (0)
    if (u0 < u1) { const AttnU un = attn_decode(u0); ATTN_ISSUE(un); }
    for (int idx = u0; idx < u1; ++idx) {
        const AttnU cu = attn_decode(idx);
        const int b = cu.b, h = cu.h, g = cu.g, d = cu.d, r = cu.r, nb = cu.nb, jstart = cu.jstart;
        const size_t rowb = (size_t)b * SEQ;
        const int iq = 32 * qt + l31, tq = (nb * 128 + iq) * d + r;
        const bf16_t* qp = bufA + (rowb + tq) * 2560 + (g * 4 + h) * 128 + 8 * h2;
        bf16x8 qf[8];
#pragma unroll
        for (int ks = 0; ks < 8; ++ks) qf[ks] = *(const bf16x8*)(qp + 16 * ks);
        __syncthreads();
#pragma unroll
        for (int it = 0; it < 8; ++it) { const int e = tid + 512 * it, j = e >> 4, ch = e & 15;
            if (j >= jstart) { const int o = 256 * j + 16 * (ch ^ (j & 15)); *(LAS u32x4*)(Ks + o) = kreg[it]; *(LAS u32x4*)(Vs + o) = vreg[it]; } }
        __syncthreads();
        if (idx + 1 < u1) { const AttnU un = attn_decode(idx + 1); ATTN_ISSUE(un); }
        f32x16 o0 = {}, o1 = {}; float den = 0.f;
        const int kb0 = (jstart >> 5) > qt ? (jstart >> 5) : qt;
        for (int kb = kb0; kb <= qt + 4; ++kb) {
            f32x16 s = zero16();
            const int key = 32 * kb + l31, sw = key & 15; const LAS unsigned char* kr = Ks + 256 * key;
#pragma unroll
            for (int ks = 0; ks < 8; ++ks) { const bf16x8 av = *(const LAS bf16x8*)(kr + 16 * ((2 * ks + h2) ^ sw)); s = MFMA32(av, qf[ks], s); }
            bf16x8 vfr[2][2];
#pragma unroll
            for (int s2 = 0; s2 < 2; ++s2) { const int key0 = 32 * kb + 16 * s2 + 4 * h2 + q4, key1 = key0 + 8;
#pragma unroll
                for (int dbi = 0; dbi < 2; ++dbi) { const int chunk = 4 * (dbase + dbi) + 2 * blk + (p4 >> 1);
                    const s16x4 lo = vtr(Vs + 256 * key0 + 16 * (chunk ^ (key0 & 15)) + 8 * (p4 & 1));
                    const s16x4 hi = vtr(Vs + 256 * key1 + 16 * (chunk ^ (key1 & 15)) + 8 * (p4 & 1)); vfr[s2][dbi] = cat8(lo, hi); } }
            const bool interior = (kb > qt) && (kb < qt + 4);
            if (interior) {
#pragma unroll
                for (int reg = 0; reg < 16; ++reg) { const float p = __builtin_amdgcn_exp2f(s[reg]); s[reg] = p; den += p; }
            } else {
#pragma unroll
                for (int reg = 0; reg < 16; ++reg) { const int j = 32 * kb + crow(reg, h2); const bool ok = (j >= iq) && (j <= iq + 128);
                    const float p = ok ? __builtin_amdgcn_exp2f(s[reg]) : 0.f; s[reg] = p; den += p; }
            }
#pragma unroll
            for (int s2 = 0; s2 < 2; ++s2) { const bf16x8 pb = pack8(s, s2);
                o0 = MFMA32(vfr[s2][0], pb, o0); o1 = MFMA32(vfr[s2][1], pb, o1); }
        }
        den += __shfl_xor(den, 32);
        bf16_t* op = OG + (size_t)g * T * 512 + (rowb + tq) * 512 + h * 128 + 4 * h2;
#pragma unroll
        for (int rg = 0; rg < 4; ++rg) {
            u32x2 v0; v0.x = pk2(o0[4 * rg], o0[4 * rg + 1]); v0.y = pk2(o0[4 * rg + 2], o0[4 * rg + 3]); *(u32x2*)(op + 32 * dbase + 8 * rg) = v0;
            u32x2 v1; v1.x = pk2(o1[4 * rg], o1[4 * rg + 1]); v1.y = pk2(o1[4 * rg + 2], o1[4 * rg + 3]); *(u32x2*)(op + 32 * (dbase + 1) + 8 * rg) = v1; }
        if ((w & 1) == 0 && h2 == 0) DEN[(rowb + tq) * 12 + h * 3 + g] = den;
    }
#undef ATTN_ISSUE
}
DI void ab_task(const bf16_t* xb, const bf16_t* wabT, const float* rowss, float* ABUF, int bid, int G) {
    int t = threadIdx.x; asm volatile("" : "+v"(t));
    const int lane = t & 63, w = __builtin_amdgcn_readfirstlane(t >> 6), li = lane & 15, lg = lane >> 4;
    for (int blk = bid * 8 + w; blk < T / 16; blk += G * 8) {
        const int row0 = blk * 16;
        const bf16_t* ap = xb + (size_t)(row0 + li) * 1024 + 8 * lg; const bf16_t* bp = wabT + (size_t)li * 1024 + 8 * lg;
        f32x4 acc = {0.f, 0.f, 0.f, 0.f};
#pragma unroll 16
        for (int c = 0; c < 32; ++c) acc = __builtin_amdgcn_mfma_f32_16x16x32_bf16(*(const bf16x8*)(ap + 32 * c), *(const bf16x8*)(bp + 32 * c), acc, 0, 0, 0);
#pragma unroll
        for (int e = 0; e < 4; ++e) { const int row = row0 + 4 * lg + e; ABUF[(size_t)row * 16 + li] = acc[e] * rowscale(rowss, row); }
    }
}
DI void combine_pass(bf16_t* OG, const float* DEN, int hid, int HN) {
    const size_t n8 = (size_t)T * 64, G1 = (size_t)T * 512;
    int tid_raw = threadIdx.x; asm volatile("" : "+v"(tid_raw));
    for (size_t i = (size_t)hid * 512 + tid_raw; i < n8; i += (size_t)HN * 512) { const size_t t = i >> 6; const int h = (int)(i & 63) >> 4;
        const float* dp = DEN + t * 12 + h * 3; const float inv = 1.f / (dp[0] + dp[1] + dp[2]);
        f32x4 a0, b0, a1, b1, a2, b2; unpk8(*(const u32x4*)(OG + i * 8), a0, b0); unpk8(*(const u32x4*)(OG + G1 + i * 8), a1, b1); unpk8(*(const u32x4*)(OG + 2 * G1 + i * 8), a2, b2);
        *(u32x4*)(OG + i * 8) = pk8((a0 + a1 + a2) * inv, (b0 + b1 + b2) * inv); }
}


DI u32x4 ld16_agent(const void* p) { const unsigned long long* q = (const unsigned long long*)p;
    const unsigned long long a = __hip_atomic_load(q, __ATOMIC_RELAXED, __HIP_MEMORY_SCOPE_AGENT), b = __hip_atomic_load(q + 1, __ATOMIC_RELAXED, __HIP_MEMORY_SCOPE_AGENT);
    return (u32x4){(unsigned)a, (unsigned)(a >> 32), (unsigned)b, (unsigned)(b >> 32)}; }
DI unsigned ld2_agent(const bf16_t* p) { return (unsigned)__hip_atomic_load(p, __ATOMIC_RELAXED, __HIP_MEMORY_SCOPE_AGENT); }
constexpr int G_QT = 0, G_KT = 16384, G_VT = 32768, G_OST = 65536, G_ABS = 98304, G_SEG = 102400, G_BL = 104448, G_GN = 104960, G_WU = 105984;
constexpr int GLA_UNITS = 64 * 32;
DI void gla1_phase(LAS unsigned char* lds, bf16_t* bufB, const float* ABUF, const float* wup, const float* ba, float* BLG, int bid, int G) {
    int tid_raw = threadIdx.x; asm volatile("" : "+v"(tid_raw));
#define GLA_IDS() int tid = tid_raw; asm volatile("" : "+v"(tid)); const int lane = tid & 63, l31 = lane & 31, h2 = lane >> 5, q4 = (lane & 15) >> 2, p4 = lane & 3, blk = (lane >> 4) & 1, dch = tid & 127, seg = tid >> 7; (void)l31; (void)h2; (void)q4; (void)p4; (void)blk; (void)dch; (void)seg
    LAS unsigned char* QT = lds + G_QT; LAS unsigned char* KT = lds + G_KT; LAS unsigned char* OST = lds + G_OST;
    LAS float* ABS = (LAS float*)(lds + G_ABS); LAS float* SEG = (LAS float*)(lds + G_SEG); LAS float* WU = (LAS float*)(lds + G_WU);
    int hprev = -1;
    f32x2 p_ab = {0.f, 0.f}; u32x4 p_q[2], p_k[2];
#define GLA1_ISSUE(UN) do { int t_ = tid_raw; asm volatile("" : "+v"(t_)); const int st_ = (UN) >> 5, c_ = (UN) & 31, b_ = st_ >> 2, h_ = st_ & 3; const size_t tk_ = (size_t)b_ * SEQ + c_ * 64; \
        p_ab = *(const f32x2*)(ABUF + tk_ * 16 + 2 * t_); \
        _Pragma("unroll") for (int i = 0; i < 2; ++i) { const int e = t_ + 512 * i, row = e >> 4, ch = e & 15; const bf16_t* src = bufB + (tk_ + row) * 2048 + h_ * 128 + ch * 8; p_q[i] = *(const u32x4*)src; p_k[i] = *(const u32x4*)(src + 512); } } while (0)
    if (bid < GLA_UNITS) GLA1_ISSUE(bid);
#pragma nounroll
    for (int unit = bid; unit < GLA_UNITS; unit += G) {
        const int st = unit >> 5, c = unit & 31, b = st >> 2, h = st & 3;
        const size_t tok0 = (size_t)b * SEQ + c * 64;
        __syncthreads();
        if (h != hprev) { GLA_IDS(); hprev = h;
            if (tid < 128) {
#pragma unroll
                for (int r = 0; r < 16; ++r) WU[r * 128 + tid] = wup[r * 512 + h * 128 + tid];
                WU[16 * 128 + tid] = ba[h * 128 + tid]; } }
        { GLA_IDS();
        *(LAS f32x2*)(ABS + 2 * tid) = p_ab;
#pragma unroll
        for (int i = 0; i < 2; ++i) { const int e = tid + 512 * i, row = e >> 4, ch = e & 15; *(LAS u32x4*)(OST + 256 * row + 16 * ch) = p_q[i]; *(LAS u32x4*)(OST + 16384 + 256 * row + 16 * ch) = p_k[i]; }
        __syncthreads();
        if (unit + G < GLA_UNITS) GLA1_ISSUE(unit + G);
        unsigned qk[16];
#pragma unroll
        for (int i = 0; i < 16; ++i) { const int o2 = 256 * (16 * seg + i) + 2 * dch; qk[i] = (unsigned)*(const LAS unsigned short*)(OST + o2) | ((unsigned)*(const LAS unsigned short*)(OST + 16384 + o2) << 16); }
        float cum[16]; float run = 0.f; float zz[16];
#pragma unroll
        for (int i = 0; i < 16; ++i) zz[i] = WU[16 * 128 + dch];
#pragma unroll
        for (int r4 = 0; r4 < 4; ++r4) { const float w0 = WU[(4 * r4) * 128 + dch], w1 = WU[(4 * r4 + 1) * 128 + dch], w2 = WU[(4 * r4 + 2) * 128 + dch], w3 = WU[(4 * r4 + 3) * 128 + dch];
#pragma unroll
            for (int i = 0; i < 16; ++i) { const f32x4 av = *(const LAS f32x4*)(ABS + (16 * seg + i) * 16 + 4 * r4); zz[i] += (av[0] * w0 + av[1] * w1) + (av[2] * w2 + av[3] * w3); } }
#pragma unroll
        for (int i = 0; i < 16; ++i) { const float z = zz[i];
            const float la = (fminf(z, 0.f) - __logf(1.f + __expf(-fabsf(z)))) * 0.0625f; run += la; cum[i] = run; }
        SEG[seg * 128 + dch] = run;
        __syncthreads();
        float pre = 0.f, tot = 0.f;
#pragma unroll
        for (int s_ = 0; s_ < 4; ++s_) { const float v = SEG[s_ * 128 + dch]; tot += v; if (s_ < seg) pre += v; }
#pragma unroll
        for (int i = 0; i < 16; ++i) { const int t = 16 * seg + i; const float bi = pre + cum[i]; const float eb = __expf(bi), ebi = __builtin_amdgcn_rcpf(eb);
            const float qv = __uint_as_float(qk[i] << 16), kv = __uint_as_float(qk[i] & 0xffff0000u);
            const int o = 256 * t + 16 * ((dch >> 3) ^ (t & 15)) + 2 * (dch & 7);
            const unsigned me = pk2(qv * eb, kv * ebi), nb = (unsigned)__shfl_xor((int)me, 1);
            if (!(dch & 1)) { *(LAS unsigned*)(QT + o) = (me & 0xffffu) | (nb << 16); *(LAS unsigned*)(KT + o) = (me >> 16) | (nb & 0xffff0000u); } }
        if (seg == 3) BLG[(size_t)unit * 128 + dch] = __expf(tot);
        __syncthreads();
#pragma unroll
        for (int i = 0; i < 2; ++i) { const int e = tid + 512 * i, row = e >> 4, ch = e & 15; bf16_t* dst = bufB + (tok0 + row) * 2048 + h * 128 + ch * 8;
            *(u32x4*)dst = *(const LAS u32x4*)(QT + 256 * row + 16 * ch); *(u32x4*)(dst + 512) = *(const LAS u32x4*)(KT + 256 * row + 16 * ch); } }
    }
#undef GLA1_ISSUE
#undef GLA_IDS
}
DI void gla2_phase(LAS unsigned char* lds, const bf16_t* bufB, bf16_t* RB, const float* BLG, const float* gn, int bid, int G) {
    int tid_raw = threadIdx.x; asm volatile("" : "+v"(tid_raw));
    const int w = __builtin_amdgcn_readfirstlane(tid_raw >> 6);
#define GLA_IDS() int tid = tid_raw; asm volatile("" : "+v"(tid)); const int lane = tid & 63, l31 = lane & 31, h2 = lane >> 5, q4 = (lane & 15) >> 2, p4 = lane & 3, blk = (lane >> 4) & 1; (void)l31; (void)h2; (void)q4; (void)p4; (void)blk
    LAS unsigned char* QT = lds + G_QT; LAS unsigned char* KT = lds + G_KT; LAS unsigned char* VT = lds + G_VT; LAS unsigned char* OST = lds + G_OST;
    LAS float* BL = (LAS float*)(lds + G_BL); LAS float* GN = (LAS float*)(lds + G_GN);
    for (int st = bid; st < 64; st += G) {
        const int b = st >> 2, h = st & 3;
        __syncthreads();
        { GLA_IDS(); if (tid < 256) GN[tid] = gn[tid]; }
        f32x16 S[4];
#pragma unroll
        for (int i = 0; i < 4; ++i) S[i] = (f32x16){};
        u32x4 pq[2], pk[2], pv[4]; float pa = 0.f;
        { GLA_IDS(); const size_t tok0 = (size_t)b * SEQ;
#pragma unroll
            for (int i = 0; i < 2; ++i) { const int e = tid + 512 * i, row = e >> 4, ch = e & 15; const bf16_t* src = bufB + (tok0 + row) * 2048 + h * 128 + ch * 8; pq[i] = *(const u32x4*)src; pk[i] = *(const u32x4*)(src + 512); }
#pragma unroll
            for (int i = 0; i < 4; ++i) { const int e = tid + 512 * i, row = e >> 5, ch = e & 31; pv[i] = *(const u32x4*)(bufB + (tok0 + row) * 2048 + 1024 + h * 256 + ch * 8); }
            if (tid < 128) pa = BLG[(size_t)(st * 32) * 128 + tid]; }
#pragma nounroll
        for (int c = 0; c < 32; ++c) {
            const size_t tok0 = (size_t)b * SEQ + c * 64;
            u32x4 gate[4];
            { GLA_IDS();
#pragma unroll
            for (int i = 0; i < 2; ++i) { const int e = tid + 512 * i, row = e >> 4, ch = e & 15; *(LAS u32x4*)(QT + 256 * row + 16 * ch) = pq[i]; *(LAS u32x4*)(KT + 256 * row + 16 * ch) = pk[i]; }
#pragma unroll
            for (int i = 0; i < 4; ++i) { const int e = tid + 512 * i, row = e >> 5, ch = e & 31; *(LAS u32x4*)(VT + 512 * row + 16 * (ch ^ (row & 15))) = pv[i]; }
            if (tid < 128) BL[tid] = pa;
            __syncthreads();
            if (c + 1 < 32) { const size_t tn = tok0 + 64;
#pragma unroll
                for (int i = 0; i < 2; ++i) { const int e = tid + 512 * i, row = e >> 4, ch = e & 15; const bf16_t* src = bufB + (tn + row) * 2048 + h * 128 + ch * 8; pq[i] = *(const u32x4*)src; pk[i] = *(const u32x4*)(src + 512); }
#pragma unroll
                for (int i = 0; i < 4; ++i) { const int e = tid + 512 * i, row = e >> 5, ch = e & 31; pv[i] = *(const u32x4*)(bufB + (tn + row) * 2048 + 1024 + h * 256 + ch * 8); }
                if (tid < 128) pa = BLG[(size_t)(st * 32 + c + 1) * 128 + tid]; }
            bf16x8 vf[4];
#pragma unroll
            for (int k4 = 0; k4 < 4; ++k4) { const int row0 = 16 * k4 + 4 * h2 + q4, row1 = row0 + 8, chunk = 4 * w + 2 * blk + (p4 >> 1);
                const s16x4 lo = vtr(VT + 512 * row0 + 16 * (chunk ^ (row0 & 15)) + 8 * (p4 & 1));
                const s16x4 hi = vtr(VT + 512 * row1 + 16 * (chunk ^ (row1 & 15)) + 8 * (p4 & 1)); vf[k4] = cat8(lo, hi); }
#pragma unroll
            for (int tb = 0; tb < 2; ++tb) {
                f32x16 acc = zero16();
                const int t = 32 * tb + l31, tsw = t & 15; const LAS unsigned char* qrow = QT + 256 * t;
#pragma unroll
                for (int dkb = 0; dkb < 4; ++dkb) { const bf16x8 sf0 = pack8(S[dkb], 0), sf1 = pack8(S[dkb], 1);
#pragma unroll
                    for (int ks = 0; ks < 2; ++ks) { const int ch0 = 4 * dkb + 2 * ks;
                        const s16x4 lo = *(const LAS s16x4*)(qrow + 16 * (ch0 ^ tsw) + 8 * h2), hi = *(const LAS s16x4*)(qrow + 16 * ((ch0 + 1) ^ tsw) + 8 * h2);
                        acc = MFMA32(cat8(lo, hi), ks == 0 ? sf0 : sf1, acc); } }
#pragma unroll
                for (int sb = 0; sb <= tb; ++sb) { f32x16 X = zero16(); const int srow = 32 * sb + l31, ssw = srow & 15; const LAS unsigned char* krow_ = KT + 256 * srow;
#pragma unroll
                    for (int ks = 0; ks < 8; ++ks) { const bf16x8 av = *(const LAS bf16x8*)(krow_ + 16 * ((2 * ks + h2) ^ ssw)), bv = *(const LAS bf16x8*)(qrow + 16 * ((2 * ks + h2) ^ tsw)); X = MFMA32(av, bv, X); }
                    if (sb == tb) {
#pragma unroll
                        for (int reg = 0; reg < 16; ++reg) if (crow(reg, h2) > l31) X[reg] = 0.f; }
                    acc = MFMA32(pack8(X, 0), vf[2 * sb], acc); acc = MFMA32(pack8(X, 1), vf[2 * sb + 1], acc); }
#pragma unroll
                for (int reg = 0; reg < 16; ++reg) *(LAS unsigned short*)(OST + 512 * (32 * tb + crow(reg, h2)) + 2 * (32 * w + l31)) = (unsigned short)pk2(acc[reg], 0.f);
            }
            { const int t = tid >> 3, s8 = tid & 7; const bf16_t* rp = RB + (tok0 + t) * 1024 + h * 256 + 32 * s8;
#pragma unroll
                for (int i = 0; i < 4; ++i) gate[i] = *(const u32x4*)(rp + 8 * i); }
#pragma unroll
            for (int dkb = 0; dkb < 4; ++dkb) {
#pragma unroll
                for (int k4 = 0; k4 < 4; ++k4) { const int key0 = 16 * k4 + 4 * h2 + q4, key1 = key0 + 8, chunk = 4 * dkb + 2 * blk + (p4 >> 1);
                    const s16x4 lo = vtr(KT + 256 * key0 + 16 * (chunk ^ (key0 & 15)) + 8 * (p4 & 1));
                    const s16x4 hi = vtr(KT + 256 * key1 + 16 * (chunk ^ (key1 & 15)) + 8 * (p4 & 1));
                    S[dkb] = MFMA32(cat8(lo, hi), vf[k4], S[dkb]); }
#pragma unroll
                for (int rg = 0; rg < 4; ++rg) { const f32x4 dv = *(const LAS f32x4*)(BL + 32 * dkb + 8 * rg + 4 * h2);
                    S[dkb][4 * rg] *= dv[0]; S[dkb][4 * rg + 1] *= dv[1]; S[dkb][4 * rg + 2] *= dv[2]; S[dkb][4 * rg + 3] *= dv[3]; }
            }
            }
            __syncthreads();
            { GLA_IDS(); const int t = tid >> 3, s8 = tid & 7; const LAS u32x4* orow = (const LAS u32x4*)(OST + 512 * t + 64 * s8);
                f32x4 ov[8]; float ss = 0.f;
#pragma unroll
                for (int i = 0; i < 4; ++i) { unpk8(orow[i], ov[2 * i], ov[2 * i + 1]); }
#pragma unroll
                for (int i = 0; i < 8; ++i) ss += (ov[i][0] * ov[i][0] + ov[i][1] * ov[i][1]) + (ov[i][2] * ov[i][2] + ov[i][3] * ov[i][3]);
                ss += __shfl_xor(ss, 1); ss += __shfl_xor(ss, 2); ss += __shfl_xor(ss, 4);
                const float rn = rsqrtf(ss * (1.f / 256.f) + EPS);
                bf16_t* rp = RB + (tok0 + t) * 1024 + h * 256 + 32 * s8;
#pragma unroll
                for (int i = 0; i < 4; ++i) { f32x4 ra, rb2; unpk8(gate[i], ra, rb2);
                    const f32x4 g0 = *(const LAS f32x4*)(GN + 32 * s8 + 8 * i), g1 = *(const LAS f32x4*)(GN + 32 * s8 + 8 * i + 4);
                    *(u32x4*)(rp + 8 * i) = pk8(ov[2 * i] * rn * g0 * ra, ov[2 * i + 1] * rn * g1 * rb2); } }
        }
    }
#undef GLA_IDS
}
#define XB_TMO      128
#define XB_XCNT(j)  (256  + 64 * (j))
#define XB_XSUB(j)  (1280 + 64 * (j))
#define XB_XGEN(j)  (2304 + 64 * (j))
#define XB_TOP      3328
#define XB_TOPGEN   3392
#define XCD_BAR_WORDS 3456
#define XB_SPIN_CAP (1u << 18)

__device__ __forceinline__ unsigned xb_ld(unsigned* p)              { return __hip_atomic_load(p, __ATOMIC_RELAXED, __HIP_MEMORY_SCOPE_AGENT); }
__device__ __forceinline__ unsigned xb_add(unsigned* p, unsigned v) { return __hip_atomic_fetch_add(p, v, __ATOMIC_RELAXED, __HIP_MEMORY_SCOPE_AGENT); }
__device__ __forceinline__ unsigned xb_xcc_id() { return (unsigned)__builtin_amdgcn_s_getreg((3 << 11) | 20) & 0xFu; }
#define XB_SPIN(cond, bar) do { unsigned _sp = 0; while (cond) { __builtin_amdgcn_s_sleep(1); \
    if ((++_sp & 255u) == 0u) { if (xb_ld(&(bar)[XB_TMO])) break; if (_sp > XB_SPIN_CAP) { atomicAdd(&(bar)[XB_TMO], 1u); break; } } } } while (0)

struct XcdBarrier {
    unsigned* bar; unsigned x;
    volatile LAS unsigned* st;
};

__device__ __forceinline__ XcdBarrier xcd_barrier_post(unsigned* bar, volatile LAS unsigned* st) {
    XcdBarrier b; b.bar = bar; b.x = xb_xcc_id(); b.st = st;
    if (threadIdx.x == 0) (void)xb_add(&bar[XB_XCNT(b.x)], 1u);
    return b;
}
__device__ __forceinline__ void xcd_barrier_complete(unsigned* bar, unsigned x, unsigned& nloc, unsigned& nx) {
    const unsigned G = gridDim.x * gridDim.y * gridDim.z;
    unsigned sum, cnt, mine, sp = 0u;
    for (;;) {
        sum = 0u; cnt = 0u; mine = 0u;
#pragma unroll
        for (unsigned j = 0; j < 16; ++j) { const unsigned c = xb_ld(&bar[XB_XCNT(j)]); sum += c; cnt += (c > 0u) ? 1u : 0u; mine = (j == x) ? c : mine; }
        if (sum == G) break;
        __builtin_amdgcn_s_sleep(1);
        if ((++sp & 255u) == 0u) { if (xb_ld(&bar[XB_TMO])) break; if (sp > XB_SPIN_CAP) { atomicAdd(&bar[XB_TMO], 1u); break; } }
    }
    nloc = mine > 0u ? mine : 1u; nx = cnt > 0u ? cnt : 1u;
}

__device__ __forceinline__ void xcd_barrier(const XcdBarrier& b) {
    asm volatile("s_waitcnt vmcnt(0)" ::: "memory");
    __syncthreads();
    if (threadIdx.x == 0) {
        unsigned* bar = b.bar;
        __builtin_amdgcn_s_waitcnt(0);
        unsigned nloc = b.st[0], nx = b.st[1];
        if (nloc == 0u) { xcd_barrier_complete(bar, b.x, nloc, nx); b.st[0] = nloc; b.st[1] = nx; }
        const unsigned old = xb_add(&bar[XB_XSUB(b.x)], 1u);
        const unsigned gen = old / nloc;
        if (old + 1u == (gen + 1u) * nloc) {
            __builtin_amdgcn_fence(__ATOMIC_RELEASE, "agent");
            asm volatile("s_waitcnt vmcnt(0)" ::: "memory");
            const unsigned og = xb_add(&bar[XB_TOP], 1u);
            const unsigned tg = og / nx;
            if (og + 1u == (tg + 1u) * nx) xb_add(&bar[XB_TOPGEN], 1u);
            else XB_SPIN(xb_ld(&bar[XB_TOPGEN]) == tg, bar);
            __builtin_amdgcn_fence(__ATOMIC_ACQUIRE, "agent");
            xb_add(&bar[XB_XGEN(b.x)], 1u);
            asm volatile("s_waitcnt vmcnt(0)" ::: "memory");
        } else {
            XB_SPIN(xb_ld(&bar[XB_XGEN(b.x)]) == gen, bar);
            __builtin_amdgcn_fence(__ATOMIC_ACQUIRE, "agent");
            asm volatile("s_waitcnt vmcnt(0)" ::: "memory");
        }
    }
    __syncthreads();
}

__global__ void __launch_bounds__(512, 2) hybrid_fwd(Args a) {
    extern __shared__ __attribute__((aligned(16))) unsigned char lds_raw[];
    LAS unsigned char* lds = (LAS unsigned char*)lds_raw;
    cg::grid_group grid = cg::this_grid();
#define GRID_SYNC_CG() do { asm volatile("s_waitcnt vmcnt(0)" ::: "memory"); grid.sync(); asm volatile("s_waitcnt vmcnt(0)" ::: "memory"); __builtin_amdgcn_s_barrier(); asm volatile("" ::: "memory"); } while (0)
#define GRID_SYNC() xcd_barrier(xbar)
    const int wave = __builtin_amdgcn_readfirstlane((int)threadIdx.x >> 6);
    const int bid = blockIdx.x, G = gridDim.x;
    volatile LAS unsigned* xst = (volatile LAS unsigned*)(lds + LDS_BYTES - 64);
    if (threadIdx.x < 2) xst[threadIdx.x] = 0u;
    __syncthreads();
    const XcdBarrier xbar = xcd_barrier_post((unsigned*)(a.ws + WS_BAR), xst);
    unsigned char* ws = a.ws;
#define XB ((bf16_t*)(ws + WS_XB))
#define OG ((bf16_t*)(ws + WS_R + R_OG))
#define BUFA ((bf16_t*)(ws + WS_R + R_BUFA))
#define BUFB ((bf16_t*)(ws + WS_R + R_BUFB))
#define RBB ((bf16_t*)(ws + WS_R + R_RB))
#define GA ((bf16_t*)(ws + WS_R + R_GA))
#define GB ((bf16_t*)(ws + WS_GB))
#define HB ((bf16_t*)(ws + WS_R + R_HB))
#define ROPE ((float*)(ws + WS_ROPE))
#define ABUF ((float*)(ws + WS_AB))
#define DEN ((float*)(ws + WS_DEN))
    float* xout = a.out;
    LAS float* cscr = (LAS float*)(lds + wave * 8704);

    {
        float* ROWSS = (float*)(ws + WS_ROWSS);
        int tid = threadIdx.x; asm volatile("" : "+v"(tid)); const int lane = tid & 63;
        const int gw = bid * 8 + wave, ngw = G * 8;
        conv_layer(a, 0, ws, cscr, gw, ngw);
        const float* x = a.in[0];
        for (int m = gw; m < T; m += ngw) { const f32x4* xr = (const f32x4*)(x + (size_t)m * 1024) + lane; float s = 0.f; u32x2* o8 = (u32x2*)(XB + (size_t)m * 1024) + lane;
#pragma unroll
            for (int j = 0; j < 4; ++j) { const f32x4 v = xr[64 * j]; s += (v[0] * v[0] + v[1] * v[1]) + (v[2] * v[2] + v[3] * v[3]); u32x2 o; o.x = pk2(v[0], v[1]); o.y = pk2(v[2], v[3]); o8[64 * j] = o; }
            s = wave_sum(s); if (lane < 16) ROWSS[(size_t)m * 16 + lane] = (lane == 0) ? s : 0.f; }
        const size_t gt = (size_t)bid * 512 + tid, ngt = (size_t)G * 512;
        const int* pos = (const int*)a.in[1];
        for (size_t i = gt; i < (size_t)T * 64; i += ngt) { const int t = (int)(i >> 6), f = (int)(i & 63);
            const float inv_freq = powf(10000.f, -(float)(2 * f) / 128.f); const float ang = (float)pos[t] * inv_freq;
            double rev = (double)ang * 0.15915494309189535; rev -= floor(rev); const float fr = (float)rev;
            typedef _Float16 h2_t __attribute__((ext_vector_type(2))); const h2_t hv = {(_Float16)__builtin_amdgcn_cosf(fr), (_Float16)__builtin_amdgcn_sinf(fr)};
            ((unsigned*)ROPE)[i] = __builtin_bit_cast(unsigned, hv); }
    }
    GRID_SYNC_CG();

    for (int l0 = 0; l0 < DEPTH; ++l0) {
#define PHASE_PTRS() int l = l0; asm volatile("" : "+s"(l)); unsigned char* wb = ws + (size_t)(l & 1) * W_LAYER; float* ROWSS = (float*)(ws + WS_ROWSS); \
        const float* ss1 = ROWSS; float* ss2 = ROWSS + (size_t)T * 16; float* ss1n = ROWSS; (void)wb; (void)ss1; (void)ss2; (void)ss1n
        { PHASE_PTRS(); Gemm g{XB, (const bf16_t*)(wb + W_INA), T, 2560, 1024}; StaticOrder S; S.init(T, 2560, G, bid);
          EpiInA E{BUFA, ss1, a.in[4] + l * 128, a.in[5] + l * 128, ROPE, (LAS float*)(lds + EPI_LDS), QSCALE};
#ifndef NO_G1
          gemm_phase<EpiInA, StaticOrder, true, true>(lds, g, S, E);
#endif
        }
        GRID_SYNC();
#ifndef NO_ATTN
        attn_phase(lds, (const bf16_t*)(ws + WS_R + R_BUFA), (bf16_t*)(ws + WS_R + R_OG), (float*)(ws + WS_DEN), (G % 8 == 0) ? (bid % 8) * (G / 8) + bid / 8 : bid, G);
#endif
        GRID_SYNC();
        { PHASE_PTRS(); ab_task(XB, (const bf16_t*)(wb + W_INB) + (size_t)3072 * 1024, ss1, ABUF, bid, G);
          Gemm g{XB, (const bf16_t*)(wb + W_INB), T, 3072, 1024}; StaticOrder S; S.init(T, 3072, G, bid);
          EpiInB E{BUFB, RBB, ABUF, ss1, (LAS float*)(lds + EPI_LDS) + 2048};
#ifndef NO_G2
          gemm_phase<EpiInB, StaticOrder, true, true>(lds, g, S, E);
#endif
        }
        GRID_SYNC();
        { PHASE_PTRS();
          combine_pass(OG, DEN, bid, G);
#ifndef NO_GLA
          gla1_phase(lds, BUFB, ABUF, a.in[6] + (size_t)l * 16 * 512, a.in[7] + l * 512, (float*)(ws + WS_BLG), bid, G);
#endif
        }
        GRID_SYNC();
        { PHASE_PTRS();
#ifndef NO_GLA
        if (G <= 64 || bid < 64) gla2_phase(lds, BUFB, RBB, (const float*)(ws + WS_BLG), a.in[8] + l * 256, bid, G <= 64 ? G : 64);
#endif
        if (G <= 64 || bid >= 64) { const int hid = G <= 64 ? bid : bid - 64, HN = G <= 64 ? G : G - 64;
            __syncthreads();
            if (l + 1 < DEPTH) conv_layer(a, l + 1, ws + (size_t)((l + 1) & 1) * W_LAYER, cscr, hid * 8 + wave, HN * 8);
            __syncthreads();
            Gemm g{XB, (const bf16_t*)(wb + W_INC), T, 2048, 1024}; StaticOrder S; S.init(T, 2048, HN, hid);
            EpiInC E{GA, GB, ss1, (LAS float*)(lds + EPI_LDS) + 2048};
#ifndef NO_G3
            gemm_phase<EpiInC, StaticOrder, true, true>(lds, g, S, E);
#endif
        } }
        GRID_SYNC();
        { PHASE_PTRS(); Gemm g{OG, (const bf16_t*)(wb + W_PA), T, 1024, 512}; StaticOrder S; S.init(T, 1024, G, bid);
          EpiProj<0> E{GA, GB};
#ifndef NO_G4
          gemm_phase<EpiProj<0>, StaticOrder, true, true>(lds, g, S, E);
#endif
        }
        { PHASE_PTRS(); Gemm g{RBB, (const bf16_t*)(wb + W_PB), T, 1024, 1024}; StaticOrder S; S.init(T, 1024, G, bid);
          EpiProj<1> E{GA, GB};
#ifndef NO_G5
          gemm_phase<EpiProj<1>, StaticOrder, true, true>(lds, g, S, E);
#endif
        }
        GRID_SYNC();
        { PHASE_PTRS(); Gemm g{GA, (const bf16_t*)(wb + W_OUT), T, 1024, 1024}; StaticOrder S; S.init(T, 1024, G, bid);
          EpiRes E{l == 0 ? a.in[0] : xout, xout, XB, ss2, 0};
#ifndef NO_G6
          gemm_phase<EpiRes, StaticOrder, true, true>(lds, g, S, E);
#endif
        }
        GRID_SYNC();
        { PHASE_PTRS(); Gemm g{XB, (const bf16_t*)(wb + W_GU), T, 5632, 1024}; StaticOrder S; S.init(T, 5632, G, bid);
          EpiFFN E{HB, ss2, (LAS float*)(lds + EPI_LDS) + 2048};
#ifndef NO_G7
          gemm_phase<EpiFFN, StaticOrder, true, true>(lds, g, S, E);
#endif
        }
        GRID_SYNC();
        { PHASE_PTRS(); Gemm g{HB, (const bf16_t*)(wb + W_D), T, 1024, 2816}; StaticOrder S; S.init(T, 1024, G, bid);
          EpiRes E{xout, xout, XB, ss1n, l + 1 == DEPTH};
#ifndef NO_G8
          gemm_phase<EpiRes, StaticOrder, true, true>(lds, g, S, E);
#endif
        }
        if (l0 + 1 < DEPTH) GRID_SYNC();
    }
}

extern "C" void kernel_launch(void* const* d_in, const int* in_sizes, int n_in, void* d_out, int out_size, void* d_ws, size_t ws_size, hipStream_t stream) {
    static int grid = 0;
    if (grid == 0) {
        if (n_in != 16 || out_size != T * 1024 || ws_size < WS_END) { fprintf(stderr, "kernel_launch: unexpected shapes (n_in %d, out %d, ws %zu)\n", n_in, out_size, ws_size); grid = -1; return; }
        int dev = 0, cus = 0, per_cu = 0;
        hipGetDevice(&dev); hipDeviceGetAttribute(&cus, hipDeviceAttributeMultiprocessorCount, dev);
        hipFuncSetAttribute((const void*)hybrid_fwd, hipFuncAttributeMaxDynamicSharedMemorySize, LDS_BYTES);
        hipOccupancyMaxActiveBlocksPerMultiprocessor(&per_cu, (const void*)hybrid_fwd, 512, LDS_BYTES);
        if (per_cu < 1) per_cu = 1;
        (void)hipGetLastError();
        grid = cus * per_cu;
    }
    if (grid < 0) return;
    if (hipMemsetAsync((char*)d_ws + WS_BAR, 0, 16384, stream) != hipSuccess) { fprintf(stderr, "kernel_launch: memset of the barrier words failed\n"); return; }
    Args a{};
    for (int i = 0; i < 16; ++i) a.in[i] = (const float*)d_in[i];
    a.out = (float*)d_out; a.ws = (unsigned char*)d_ws;
    void* args[] = {&a};
    hipError_t e = hipLaunchCooperativeKernel((const void*)hybrid_fwd, dim3(grid), dim3(512), args, LDS_BYTES, stream);
    if (e != hipSuccess) fprintf(stderr, "cooperative launch failed: %s (grid %d)\n", hipGetErrorString(e), grid);
}
```

```cpp
#include <hip/hip_runtime.h>
#include <hip/hip_cooperative_groups.h>
#include <cstdio>
#include <cstdint>
namespace cg = cooperative_groups;

namespace pg8 {
#define PG8_LAS __attribute__((address_space(3)))
typedef unsigned short bf16_t;
typedef short bf16x8 __attribute__((ext_vector_type(8)));
typedef float f32x4 __attribute__((ext_vector_type(4)));
typedef unsigned u32x4 __attribute__((ext_vector_type(4)));
constexpr int BM = 256, BK = 64, HALF = 128, HTB = HALF * BK * 2  , STAGE_BYTES = 8 * HTB, NXCD = 8, WGM = 8;

__host__ __device__ __forceinline__ int lds_byte(int r, int c) { const int st = (r >> 4) * 2 + (c >> 5), rr = r & 15, cc = c & 31, ob = rr * 64 + cc * 2; return st * 1024 + (ob ^ (((ob >> 9) & 1) << 5)); }
__host__ __device__ __forceinline__ void stage_rc(int b, int& R, int& C) { const int st = b / 1024, sb = b % 1024, swz = sb ^ (((sb >> 9) & 1) << 5); R = (st >> 1) * 16 + swz / 64; C = (st & 1) * 32 + (swz % 64) / 2; }
__host__ __device__ __forceinline__ int perm32(int rho) { const int n = rho >> 4, i = rho & 15; return 8 * (i >> 2) + 4 * n + (i & 3); }

struct Unit { int pm, pn; };
struct Gemm { const bf16_t* A; const bf16_t* Bt; int M, N, K; };

struct StaticOrder {
    int nM, nN, nwg, G, c;
    __host__ __device__ void init(int M, int N, int G_, int c_) { nM = M / BM; nN = N / BM; nwg = nM * nN; G = G_; c = c_; }
    __host__ __device__ bool next(int i, Unit& u) const {
        const long L = (long)i * G + c; if (L >= nwg) return false;
        int wgid = (int)L; { const int q = nwg / NXCD, r = nwg % NXCD, xcd = wgid % NXCD, off = wgid / NXCD; wgid = (xcd < r ? xcd * (q + 1) : r * (q + 1) + (xcd - r) * q) + off; }
        const int nig = WGM * nN, gid = wgid / nig, fm = gid * WGM, gsz = (nM - fm) < WGM ? (nM - fm) : WGM;
        u.pm = fm + ((wgid % nig) % gsz); u.pn = (wgid % nig) / gsz; return true;
    }
    __device__ __forceinline__ void a_ready(const Unit&) const {}
    __device__ __forceinline__ void done(const Unit&) const {}
};

typedef unsigned u32x2 __attribute__((ext_vector_type(2)));
typedef float f32x2 __attribute__((ext_vector_type(2)));
typedef __bf16 bf16x2_t __attribute__((ext_vector_type(2)));
constexpr float EPS_ = 1e-6f;
constexpr int T_ = 32768;
__device__ __forceinline__ unsigned pk2(float lo, float hi) { f32x2 v = {lo, hi}; bf16x2_t b = __builtin_convertvector(v, bf16x2_t); return __builtin_bit_cast(unsigned, b); }
__device__ __forceinline__ u32x4 pk8(f32x4 a, f32x4 b) { u32x4 w; w.x = pk2(a[0], a[1]); w.y = pk2(a[2], a[3]); w.z = pk2(b[0], b[1]); w.w = pk2(b[2], b[3]); return w; }
__device__ __forceinline__ float bflo(unsigned w) { return __uint_as_float(w << 16); }
__device__ __forceinline__ float bfhi(unsigned w) { return __uint_as_float(w & 0xffff0000u); }
__device__ __forceinline__ void unpk8(u32x4 w, f32x4& a, f32x4& b) { a = (f32x4){bflo(w.x), bfhi(w.x), bflo(w.y), bfhi(w.y)}; b = (f32x4){bflo(w.z), bfhi(w.z), bflo(w.w), bfhi(w.w)}; }
__device__ __forceinline__ float sigm(float x) { return __builtin_amdgcn_rcpf(1.f + __expf(-x)); }
__device__ __forceinline__ f32x4 sigm4(f32x4 v) { return (f32x4){sigm(v[0]), sigm(v[1]), sigm(v[2]), sigm(v[3])}; }
__device__ __forceinline__ f32x4 silu4(f32x4 v) { return v * sigm4(v); }
__device__ __forceinline__ float rowscale(const float* rowss, int row) { const f32x4* p = (const f32x4*)(rowss + (size_t)row * 16); const f32x4 a = p[0], b = p[1], c = p[2], d = p[3];
    const float s = (((a[0] + a[1]) + (a[2] + a[3])) + ((b[0] + b[1]) + (b[2] + b[3]))) + (((c[0] + c[1]) + (c[2] + c[3])) + ((d[0] + d[1]) + (d[2] + d[3])));
    return rsqrtf(s * (1.f / 1024.f) + EPS_); }
__device__ __forceinline__ void stage_rowscale(PG8_LAS float* RS, const float* rowss, int pm) {
    int t = threadIdx.x; asm volatile("" : "+v"(t));
    if (t < 256) RS[t] = rowscale(rowss, pm * 256 + t);
    asm volatile("s_waitcnt lgkmcnt(0)" ::: "memory"); __builtin_amdgcn_s_barrier(); asm volatile("" ::: "memory");
}
#define EPI_ROWS(ai, m) _Pragma("unroll") for (int ai = 0; ai < 2; ++ai) _Pragma("unroll") for (int m = 0; m < 4; ++m)
#define EPI_FENCE(m) do { if ((m) & 1) asm volatile("" ::: "memory"); } while (0)

struct EpiInA {
    static constexpr bool PERM = true, AFTER_DRAIN = false;
    bf16_t* out; const float* rowss; const float* qn; const float* kn; const float* rope; PG8_LAS float* P; float qscale;
    __device__ __forceinline__ void operator()(const f32x4 (&acc)[2][2][4][2], const Unit& u, int wr, int wc, int fr, int fq) const {
        int rl0 = wr * 64 + fr; asm volatile("" : "+v"(rl0)); const int col0 = u.pn * 256 + wc * 32 + 8 * fq;
        stage_rowscale(P + 2048, rowss, u.pm);
        if (u.pn < 8) {
            EPI_ROWS(ai, m) { const int rl = ai * 128 + rl0 + m * 16; const float rs = P[2048 + rl];
#pragma unroll
                for (int bj = 0; bj < 2; ++bj) { const f32x4 a = acc[ai][bj][m][0] * rs, b = acc[ai][bj][m][1] * rs;
                    float ss = (a[0] * a[0] + a[1] * a[1]) + (a[2] * a[2] + a[3] * a[3]) + (b[0] * b[0] + b[1] * b[1]) + (b[2] * b[2] + b[3] * b[3]);
                    ss += __shfl_xor(ss, 16); ss += __shfl_xor(ss, 32);
                    if (fq == 0) P[rl * 8 + bj * 4 + wc] = ss; }
                EPI_FENCE(m); }
            asm volatile("s_waitcnt lgkmcnt(0)" ::: "memory"); __builtin_amdgcn_s_barrier(); asm volatile("" ::: "memory");
            const float* gp = (u.pn < 6) ? qn : kn; const float sc = (u.pn < 6) ? qscale : 1.f;
            const f32x4 g0 = *(const f32x4*)(gp + 16 * wc + 4 * fq) * sc, g1 = *(const f32x4*)(gp + 64 + 16 * wc + 4 * fq) * sc;
            EPI_ROWS(ai, m) { const int rl = ai * 128 + rl0 + m * 16; const int row = u.pm * 256 + rl; const float rs = P[2048 + rl];
                const u32x4 cw = *(const u32x4*)((const unsigned*)rope + (size_t)row * 64 + 16 * wc + 4 * fq);
#define H2F_LO(w_) ((float)__builtin_bit_cast(_Float16, (unsigned short)((w_) & 0xffffu)))
#define H2F_HI(w_) ((float)__builtin_bit_cast(_Float16, (unsigned short)((w_) >> 16)))
                const f32x4 cs = {H2F_LO(cw[0]), H2F_LO(cw[1]), H2F_LO(cw[2]), H2F_LO(cw[3])}, sn = {H2F_HI(cw[0]), H2F_HI(cw[1]), H2F_HI(cw[2]), H2F_HI(cw[3])};
#pragma unroll
                for (int bj = 0; bj < 2; ++bj) { const f32x4 pp = *(const PG8_LAS f32x4*)(P + rl * 8 + bj * 4);
                    const float hn = rsqrtf(((pp[0] + pp[1]) + (pp[2] + pp[3])) * (1.f / 128.f) + EPS_) * rs;
                    const f32x4 x1 = acc[ai][bj][m][0] * hn * g0, x2 = acc[ai][bj][m][1] * hn * g1;
                    const f32x4 o1 = x1 * cs - x2 * sn, o2 = x2 * cs + x1 * sn;
                    *(u32x4*)(out + (size_t)row * 2560 + col0 + bj * 128) = pk8(o1, o2); } asm volatile("" ::: "memory"); }
        } else {
            EPI_ROWS(ai, m) { const int rl = ai * 128 + rl0 + m * 16; const int row = u.pm * 256 + rl; const float rs = P[2048 + rl];
#pragma unroll
                for (int bj = 0; bj < 2; ++bj) *(u32x4*)(out + (size_t)row * 2560 + col0 + bj * 128) = pk8(acc[ai][bj][m][0] * rs, acc[ai][bj][m][1] * rs); EPI_FENCE(m); }
        }
    }
};
struct EpiInB {
    static constexpr bool PERM = true, AFTER_DRAIN = false;
    bf16_t* out; bf16_t* rb; float* ab; const float* rowss; PG8_LAS float* RS;
    __device__ __forceinline__ void operator()(const f32x4 (&acc)[2][2][4][2], const Unit& u, int wr, int wc, int fr, int fq) const {
        int rl0 = wr * 64 + fr; asm volatile("" : "+v"(rl0)); const int cin = wc * 32 + 8 * fq;
        stage_rowscale(RS, rowss, u.pm);
        EPI_ROWS(ai, m) { const int rl = ai * 128 + rl0 + m * 16; const int row = u.pm * 256 + rl; float rs = RS[rl];
            if (u.pn < 8) { if (u.pn < 2) rs *= 0.08838834764831845f;
#pragma unroll
                for (int bj = 0; bj < 2; ++bj) *(u32x4*)(out + (size_t)row * 2048 + u.pn * 256 + cin + bj * 128) = pk8(acc[ai][bj][m][0] * rs, acc[ai][bj][m][1] * rs);
            } else if (u.pn < 12) {
#pragma unroll
                for (int bj = 0; bj < 2; ++bj) *(u32x4*)(rb + (size_t)row * 1024 + (u.pn - 8) * 256 + cin + bj * 128) = pk8(silu4(acc[ai][bj][m][0] * rs), silu4(acc[ai][bj][m][1] * rs));
            } else if (wc == 0 && fq < 2) {
                *(f32x4*)(ab + (size_t)row * 16 + 8 * fq) = acc[ai][0][m][0] * rs; *(f32x4*)(ab + (size_t)row * 16 + 8 * fq + 4) = acc[ai][0][m][1] * rs;
            } EPI_FENCE(m); }
    }
};
__device__ __forceinline__ unsigned pkq4(f32x4 v) { unsigned r = 0u; r = __builtin_amdgcn_cvt_pk_u8_f32(v[0] * 255.f, 0, r); r = __builtin_amdgcn_cvt_pk_u8_f32(v[1] * 255.f, 1, r); r = __builtin_amdgcn_cvt_pk_u8_f32(v[2] * 255.f, 2, r); r = __builtin_amdgcn_cvt_pk_u8_f32(v[3] * 255.f, 3, r); return r; }
__device__ __forceinline__ f32x4 unq4(unsigned w) { return (f32x4){(float)(w & 0xffu), (float)((w >> 8) & 0xffu), (float)((w >> 16) & 0xffu), (float)(w >> 24)} * (1.f / 255.f); }
struct EpiInC {
    static constexpr bool PERM = true, AFTER_DRAIN = false;
    unsigned char* ga; unsigned char* gb; const float* rowss; PG8_LAS float* RS;
    __device__ __forceinline__ void operator()(const f32x4 (&acc)[2][2][4][2], const Unit& u, int wr, int wc, int fr, int fq) const {
        int rl0 = wr * 64 + fr; asm volatile("" : "+v"(rl0)); unsigned char* base = (u.pn < 4) ? ga : gb; const int col0 = (u.pn & 3) * 256 + wc * 32 + 8 * fq;
        stage_rowscale(RS, rowss, u.pm);
        EPI_ROWS(ai, m) { const int rl = ai * 128 + rl0 + m * 16; const int row = u.pm * 256 + rl; const float rs = RS[rl];
#pragma unroll
            for (int bj = 0; bj < 2; ++bj) { u32x2 q; q.x = pkq4(sigm4(acc[ai][bj][m][0] * rs)); q.y = pkq4(sigm4(acc[ai][bj][m][1] * rs)); *(u32x2*)(base + (size_t)row * 1024 + col0 + bj * 128) = q; } EPI_FENCE(m); }
    }
};
template <int MODE> struct EpiProj {
    static constexpr bool PERM = true, AFTER_DRAIN = false;
    bf16_t* y; const unsigned char* gq;
    __device__ __forceinline__ void operator()(const f32x4 (&acc)[2][2][4][2], const Unit& u, int wr, int wc, int fr, int fq) const {
        int rl0 = wr * 64 + fr; asm volatile("" : "+v"(rl0)); const int col0 = u.pn * 256 + wc * 32 + 8 * fq;
        EPI_ROWS(ai, m) { const int row = u.pm * 256 + ai * 128 + rl0 + m * 16;
#pragma unroll
            for (int bj = 0; bj < 2; ++bj) { const size_t off = (size_t)row * 1024 + col0 + bj * 128; const u32x2 q = *(const u32x2*)(gq + off);
                f32x4 a = unq4(q.x) * acc[ai][bj][m][0], b = unq4(q.y) * acc[ai][bj][m][1];
                if (MODE == 1) { f32x4 c, d; unpk8(*(const u32x4*)(y + off), c, d); a = a + c; b = b + d; }
                *(u32x4*)(y + off) = pk8(a, b); } EPI_FENCE(m); }
    }
};
struct EpiRes {
    static constexpr bool PERM = true, AFTER_DRAIN = false;
    const float* xin; float* xout; bf16_t* xb; float* ssout; int last;
    __device__ __forceinline__ void operator()(const f32x4 (&acc)[2][2][4][2], const Unit& u, int wr, int wc, int fr, int fq) const {
        int rl0 = wr * 64 + fr; asm volatile("" : "+v"(rl0)); const int col0 = u.pn * 256 + wc * 32 + 8 * fq;
        EPI_ROWS(ai, m) { const int row = u.pm * 256 + ai * 128 + rl0 + m * 16; float ss = 0.f;
#pragma unroll
            for (int bj = 0; bj < 2; ++bj) { const size_t off = (size_t)row * 1024 + col0 + bj * 128;
                const f32x4 a = *(const f32x4*)(xin + off) + acc[ai][bj][m][0], b = *(const f32x4*)(xin + off + 4) + acc[ai][bj][m][1];
                *(f32x4*)(xout + off) = a; *(f32x4*)(xout + off + 4) = b; if (!last) *(u32x4*)(xb + off) = pk8(a, b);
                ss += (a[0] * a[0] + a[1] * a[1]) + (a[2] * a[2] + a[3] * a[3]) + (b[0] * b[0] + b[1] * b[1]) + (b[2] * b[2] + b[3] * b[3]); }
            ss += __shfl_xor(ss, 16); ss += __shfl_xor(ss, 32);
            if (fq == 0 && !last) ssout[(size_t)row * 16 + u.pn * 4 + wc] = ss; EPI_FENCE(m); }
    }
};
struct EpiFFN {
    static constexpr bool PERM = true, AFTER_DRAIN = false;
    bf16_t* hb; const float* rowss; PG8_LAS float* RS;
    __device__ __forceinline__ void operator()(const f32x4 (&acc)[2][2][4][2], const Unit& u, int wr, int wc, int fr, int fq) const {
        int rl0 = wr * 64 + fr; asm volatile("" : "+v"(rl0)); const int col0 = u.pn * 128 + wc * 32 + 8 * fq;
        stage_rowscale(RS, rowss, u.pm);
        EPI_ROWS(ai, m) { const int rl = ai * 128 + rl0 + m * 16; const int row = u.pm * 256 + rl; const float rs = RS[rl];
            const f32x4 a = silu4(acc[ai][0][m][0] * rs) * (acc[ai][1][m][0] * rs), b = silu4(acc[ai][0][m][1] * rs) * (acc[ai][1][m][1] * rs);
            *(u32x4*)(hb + (size_t)row * 2816 + col0) = pk8(a, b); EPI_FENCE(m); }
    }
};
template <class Epi, class Sched, bool ALIGN_EPI = false, bool SP2 = false>
__device__ __forceinline__ void gemm_phase(PG8_LAS unsigned char* lds, const Gemm g, const Sched& S, const Epi& E) {
    int tid_raw = threadIdx.x; asm volatile("" : "+v"(tid_raw));
    const int tid = tid_raw, wid = __builtin_amdgcn_readfirstlane(tid >> 6), lane = tid & 63, wr = wid >> 2, wc = wid & 3, fr = lane & 15, fq = lane >> 4;
    const int K = g.K, nt = K / BK;
    unsigned voffA[2], voffB[2];
#pragma unroll
    for (int i = 0; i < 2; ++i) { int R, C; stage_rc(tid * 16 + i * 8192, R, C); const int Rb = Epi::PERM ? ((R & ~31) + perm32(R & 31)) : R;
        voffA[i] = (unsigned)(R * K + C) * 2u; voffB[i] = (unsigned)(Rb * K + C) * 2u; }
    const size_t kstep = (size_t)(BK * 2);
    const size_t hstep = (size_t)HALF * K * 2;
    const size_t tstep = 2 * hstep;
    const unsigned ldsw = (unsigned)wid * 1024u;
    const int aoff = lds_byte(wr * 64 + fr, fq * 8), boff = lds_byte(wc * 32 + fr, fq * 8);
#define PG8_SA(b, h) (((b) * 2 + (h)) * HTB)
#define PG8_SB(b, h) ((4 + (b) * 2 + (h)) * HTB)
#define PG8_STAGE(bufoff, gbase, voff) do { _Pragma("unroll") for (int _i = 0; _i < 2; ++_i) \
        __builtin_amdgcn_global_load_lds((const unsigned*)((const char*)(gbase) + (voff)[_i]), (PG8_LAS unsigned*)(lds + (bufoff) + ldsw + _i * 8192), 16, 0, 0); } while (0)
#define PG8_LDA(dst, b, h) do { _Pragma("unroll") for (int m = 0; m < 4; ++m) _Pragma("unroll") for (int k = 0; k < 2; ++k) dst[m][k] = *(const PG8_LAS bf16x8*)(lds + PG8_SA(b, h) + aoff + m * 2048 + k * 1024); } while (0)
#define PG8_LDB(dst, b, h) do { _Pragma("unroll") for (int n = 0; n < 2; ++n) _Pragma("unroll") for (int k = 0; k < 2; ++k) dst[n][k] = *(const PG8_LAS bf16x8*)(lds + PG8_SB(b, h) + boff + n * 2048 + k * 1024); } while (0)
#define PG8_MMA(ai, bj, At, Bt) do { __builtin_amdgcn_s_setprio(1); _Pragma("unroll") for (int m = 0; m < 4; ++m) _Pragma("unroll") for (int n = 0; n < 2; ++n) _Pragma("unroll") for (int k = 0; k < 2; ++k) \
        acc[ai][bj][m][n] = __builtin_amdgcn_mfma_f32_16x16x32_bf16(Bt[n][k], At[m][k], acc[ai][bj][m][n], 0, 0, 0); __builtin_amdgcn_s_setprio(0); } while (0)
#define PG8_WAIT_V(n) asm volatile("s_waitcnt vmcnt(" #n ")" ::: "memory")
#define PG8_WAIT_L(n) asm volatile("s_waitcnt lgkmcnt(" #n ")" ::: "memory")
#define PG8_BAR __builtin_amdgcn_s_barrier()
#define PG8_SCHED __builtin_amdgcn_sched_barrier(0)
    Unit cur, nxt; int ui = 0;
    if (!S.next(0, cur)) return;
    f32x4 acc[2][2][4][2];
#pragma unroll
    for (int a = 0; a < 2; ++a)
#pragma unroll
        for (int b = 0; b < 2; ++b)
#pragma unroll
            for (int m = 0; m < 4; ++m)
#pragma unroll
                for (int n = 0; n < 2; ++n) acc[a][b][m][n] = (f32x4){0.f, 0.f, 0.f, 0.f};
    bf16x8 At[4][2], B0[2][2], B1[2][2];
    const char* cA = (const char*)g.A + (size_t)cur.pm * tstep; const char* cB = (const char*)g.Bt + (size_t)cur.pn * tstep;
    S.a_ready(cur);
    if constexpr (SP2) {
        PG8_STAGE(PG8_SB(0, 0), cB, voffB); PG8_STAGE(PG8_SB(0, 1), cB + hstep, voffB); PG8_STAGE(PG8_SA(0, 0), cA, voffA); PG8_STAGE(PG8_SA(0, 1), cA + hstep, voffA);
        if (wr == 1) PG8_BAR;
        PG8_WAIT_V(2); PG8_BAR;
        PG8_STAGE(PG8_SB(1, 0), cB + kstep, voffB); PG8_STAGE(PG8_SA(1, 0), cA + kstep, voffA); PG8_STAGE(PG8_SB(1, 1), cB + hstep + kstep, voffB);
        PG8_WAIT_V(6); PG8_BAR;
    } else {
        PG8_STAGE(PG8_SB(0, 0), cB, voffB); PG8_STAGE(PG8_SA(0, 0), cA, voffA); PG8_STAGE(PG8_SB(0, 1), cB + hstep, voffB); PG8_STAGE(PG8_SA(0, 1), cA + hstep, voffA);
        if (wr == 1) PG8_BAR;
        PG8_WAIT_V(4); PG8_BAR;
        PG8_STAGE(PG8_SB(1, 0), cB + kstep, voffB); PG8_STAGE(PG8_SA(1, 0), cA + kstep, voffA); PG8_STAGE(PG8_SB(1, 1), cB + hstep + kstep, voffB);
        PG8_WAIT_V(6); PG8_BAR;
    }
    for (;;) {
        const bool has_next = S.next(ui + 1, nxt);
        const char* nA = has_next ? (const char*)g.A + (size_t)nxt.pm * tstep : cA; const char* nB = has_next ? (const char*)g.Bt + (size_t)nxt.pn * tstep : cB;
        for (int t = 0; t < nt; t += 2) {
            const bool last = (t == nt - 2);
            const char* a1 = cA + (size_t)(t + 1) * kstep;
            const char* a2 = last ? nA : cA + (size_t)(t + 2) * kstep; const char* b2 = last ? nB : cB + (size_t)(t + 2) * kstep;
            const char* a3 = a2 + kstep; const char* b3 = b2 + kstep;
            if (last && has_next) S.a_ready(nxt);
            if constexpr (SP2) {
            PG8_LDB(B0, 0, 0); PG8_LDB(B1, 0, 1); PG8_SCHED; PG8_LDA(At, 0, 0); PG8_STAGE(PG8_SA(1, 1), a1 + hstep, voffA);
            PG8_WAIT_V(8); PG8_WAIT_L(0); PG8_BAR; PG8_MMA(0, 0, At, B0); PG8_MMA(0, 1, At, B1); PG8_BAR; PG8_SCHED;
            PG8_LDA(At, 0, 1); PG8_STAGE(PG8_SB(0, 0), b2, voffB); PG8_STAGE(PG8_SB(0, 1), b2 + hstep, voffB); PG8_STAGE(PG8_SA(0, 0), a2, voffA);
            PG8_WAIT_V(8); PG8_WAIT_L(0); PG8_BAR; PG8_MMA(1, 0, At, B0); PG8_MMA(1, 1, At, B1); PG8_BAR; PG8_SCHED;
            PG8_LDB(B0, 1, 0); PG8_LDB(B1, 1, 1); PG8_SCHED; PG8_LDA(At, 1, 0); PG8_STAGE(PG8_SA(0, 1), a2 + hstep, voffA);
            PG8_WAIT_V(8); PG8_WAIT_L(0); PG8_BAR; PG8_MMA(0, 0, At, B0); PG8_MMA(0, 1, At, B1); PG8_BAR; PG8_SCHED;
            PG8_LDA(At, 1, 1); PG8_STAGE(PG8_SB(1, 0), b3, voffB); PG8_STAGE(PG8_SB(1, 1), b3 + hstep, voffB); PG8_STAGE(PG8_SA(1, 0), a3, voffA);
            PG8_WAIT_V(8); PG8_WAIT_L(0); PG8_BAR; PG8_MMA(1, 0, At, B0); PG8_MMA(1, 1, At, B1); PG8_BAR; PG8_SCHED;
            } else {
            PG8_LDB(B0, 0, 0); PG8_SCHED; PG8_LDA(At, 0, 0); PG8_STAGE(PG8_SA(1, 1), a1 + hstep, voffA);
            PG8_WAIT_L(8); PG8_BAR; PG8_WAIT_L(0); PG8_MMA(0, 0, At, B0); PG8_BAR; PG8_SCHED;
            PG8_LDB(B1, 0, 1); PG8_STAGE(PG8_SB(0, 0), b2, voffB);
            PG8_BAR; PG8_WAIT_L(0); PG8_MMA(0, 1, At, B1); PG8_BAR;
            PG8_LDA(At, 0, 1); PG8_STAGE(PG8_SA(0, 0), a2, voffA);
            PG8_BAR; PG8_WAIT_L(0); PG8_MMA(1, 0, At, B0); PG8_BAR; PG8_SCHED;
            PG8_STAGE(PG8_SB(0, 1), b2 + hstep, voffB);
            PG8_WAIT_V(6); PG8_BAR; PG8_MMA(1, 1, At, B1); PG8_BAR;
            PG8_LDB(B0, 1, 0); PG8_SCHED; PG8_LDA(At, 1, 0); PG8_STAGE(PG8_SA(0, 1), a2 + hstep, voffA);
            PG8_WAIT_L(8); PG8_BAR; PG8_WAIT_L(0); PG8_MMA(0, 0, At, B0); PG8_BAR; PG8_SCHED;
            PG8_LDB(B1, 1, 1); PG8_STAGE(PG8_SB(1, 0), b3, voffB);
            PG8_BAR; PG8_WAIT_L(0); PG8_MMA(0, 1, At, B1); PG8_BAR;
            PG8_LDA(At, 1, 1); PG8_STAGE(PG8_SA(1, 0), a3, voffA);
            PG8_BAR; PG8_WAIT_L(0); PG8_MMA(1, 0, At, B0); PG8_BAR; PG8_SCHED;
            PG8_STAGE(PG8_SB(1, 1), b3 + hstep, voffB);
            PG8_WAIT_V(6); PG8_BAR; PG8_MMA(1, 1, At, B1); PG8_BAR;
            }
        }
        if constexpr (ALIGN_EPI) { if (wr == 0) PG8_BAR; }
        if constexpr (!Epi::AFTER_DRAIN) { E(acc, cur, wr, wc, fr, fq); S.done(cur); }
        if (!has_next) break;
#pragma unroll
        for (int a = 0; a < 2; ++a)
#pragma unroll
            for (int b = 0; b < 2; ++b)
#pragma unroll
                for (int m = 0; m < 4; ++m)
#pragma unroll
                    for (int n = 0; n < 2; ++n) acc[a][b][m][n] = (f32x4){0.f, 0.f, 0.f, 0.f};
        cur = nxt; cA = nA; cB = nB; ++ui;
        if constexpr (ALIGN_EPI) { if (wr == 1) PG8_BAR; }
    }
    PG8_WAIT_V(0);
    if constexpr (!ALIGN_EPI) { if (wr == 0) PG8_BAR; }
    PG8_BAR;
    if constexpr (Epi::AFTER_DRAIN) { E.fused(acc, cur, wr, wc, fr, fq, lds, wid, lane); S.done(cur); }
#undef PG8_SA
#undef PG8_SB
#undef PG8_STAGE
#undef PG8_LDA
#undef PG8_LDB
#undef PG8_MMA
#undef PG8_WAIT_V
#undef PG8_WAIT_L
#undef PG8_BAR
#undef PG8_SCHED
}
}
using namespace pg8;
#define LAS __attribute__((address_space(3)))
#define DI __device__ __forceinline__
typedef short s16x4 __attribute__((ext_vector_type(4)));
typedef short v4i16_t __attribute__((ext_vector_type(4)));
typedef float f32x16 __attribute__((ext_vector_type(16)));
constexpr int T = 32768, SEQ = 2048, DEPTH = 4;
constexpr float EPS = 1e-6f;
constexpr float QSCALE = 0.08838834764831845f * 1.4426950408889634f;
constexpr size_t MiB = 1u << 20, HM = 1u << 19;
constexpr size_t W_LAYER = 37 * MiB;
constexpr size_t W_INA = 0, W_INB = 5 * MiB, W_INC = 11 * MiB + HM, W_PA = 15 * MiB + HM, W_PB = 16 * MiB + HM, W_OUT = 18 * MiB + HM, W_GU = 20 * MiB + HM, W_D = 31 * MiB + HM;
constexpr size_t WS_XB = 74 * MiB, WS_R = 138 * MiB;
constexpr size_t R_OG = 0, R_BUFA = 96 * MiB, R_BUFB = 96 * MiB, R_RB = 224 * MiB, R_GA = 32 * MiB, R_GB = 96 * MiB, R_HB = 96 * MiB;
constexpr size_t WS_ROPE = 426 * MiB, WS_AB = 434 * MiB, WS_DEN = 436 * MiB, WS_ROWSS = 438 * MiB, WS_BLG = 442 * MiB, WS_BAR = 443 * MiB, WS_GB = 444 * MiB, WS_END = 508 * MiB;
constexpr int LDS_BYTES = 147456, EPI_LDS = 131072;
struct Args { const float* in[16]; float* out; unsigned char* ws; };

#define MFMA32(a, b, c) __builtin_amdgcn_mfma_f32_32x32x16_bf16((a), (b), (c), 0, 0, 0)
DI int crow(int reg, int h) { return (reg & 3) + 8 * (reg >> 2) + 4 * h; }
DI bf16x8 pack8(const f32x16& x, int s) { u32x4 p; p.x = pk2(x[8 * s], x[8 * s + 1]); p.y = pk2(x[8 * s + 2], x[8 * s + 3]); p.z = pk2(x[8 * s + 4], x[8 * s + 5]); p.w = pk2(x[8 * s + 6], x[8 * s + 7]); return __builtin_bit_cast(bf16x8, p); }
DI s16x4 vtr(const LAS unsigned char* p) { return __builtin_bit_cast(s16x4, __builtin_amdgcn_ds_read_tr16_b64_v4i16((LAS v4i16_t*)p)); }
DI bf16x8 cat8(s16x4 lo, s16x4 hi) { return __builtin_shufflevector(lo, hi, 0, 1, 2, 3, 4, 5, 6, 7); }
DI f32x16 zero16() { float z = 0.f; asm volatile("" : "+v"(z)); f32x16 r;
#pragma unroll
    for (int i = 0; i < 16; ++i) r[i] = z;
    return r; }
DI float wave_sum(float v) {
#pragma unroll
    for (int o = 1; o < 64; o <<= 1) v += __shfl_xor(v, o);
    return v;
}

DI void conv_tile(const float* src, int ldw, int K, int col, const float* ksc, bf16_t* WT, int p0, int k0, LAS float* scr, int lane) {
#pragma unroll 16
    for (int i = 0; i < 32; ++i) { const int kk = 2 * i + (lane >> 5); float v = 0.f;
        if (col >= 0) { v = src[(size_t)(k0 + kk) * ldw + col]; if (ksc) v *= ksc[k0 + kk]; }
        scr[kk * 33 + (lane & 31)] = v; }
    asm volatile("s_waitcnt lgkmcnt(0)" ::: "memory");
    const int c = lane & 7;
#pragma unroll
    for (int j = 0; j < 4; ++j) { const int n = (lane >> 3) + 8 * j; const LAS float* s = scr + (8 * c) * 33 + n;
        u32x4 o; o.x = pk2(s[0 * 33], s[1 * 33]); o.y = pk2(s[2 * 33], s[3 * 33]); o.z = pk2(s[4 * 33], s[5 * 33]); o.w = pk2(s[6 * 33], s[7 * 33]);
        *(u32x4*)(WT + (size_t)(p0 + n) * K + k0 + 8 * c) = o; }
    asm volatile("s_waitcnt lgkmcnt(0)" ::: "memory");
}
constexpr int CONV_ITEMS = 1280 + 1664 + 1024 + 256 + 512 + 512 + 2816 + 1408;
DI void conv_layer(const Args& a, int l, unsigned char* wbytes, LAS float* scr, int gw, int ngw) {
    int lane = threadIdx.x; asm volatile("" : "+v"(lane)); lane &= 63;
    const float* win = a.in[3] + (size_t)l * 1024 * 7696; const float* n1 = a.in[2] + l * 1024; const float* n2 = a.in[12] + l * 1024;
    const int pl = lane & 31;
    for (int it = gw; it < CONV_ITEMS; it += ngw) {
        int r = it;
        if (r < 1280) { const int nb = r % 80, kb = r / 80, p = 32 * nb + pl; int col = p;
            if (p < 2048) { const int w = p & 127, j = w >> 3, e = w & 7; col = (p & ~127) + (e < 4 ? 4 * j + e : 64 + 4 * j + e - 4); }
            conv_tile(win, 7696, 1024, col, n1, (bf16_t*)(wbytes + W_INA), 32 * nb, 64 * kb, scr, lane); continue; }
        r -= 1280;
        if (r < 1664) { const int nb = r % 104, kb = r / 104, p = 32 * nb + pl; const int col = p < 3072 ? 2560 + p : (p < 3088 ? 5632 + (p - 3072) : -1);
            conv_tile(win, 7696, 1024, col, n1, (bf16_t*)(wbytes + W_INB), 32 * nb, 64 * kb, scr, lane); continue; }
        r -= 1664;
        if (r < 1024) { const int nb = r % 64, kb = r / 64, p = 32 * nb + pl;
            conv_tile(win, 7696, 1024, 5648 + p, n1, (bf16_t*)(wbytes + W_INC), 32 * nb, 64 * kb, scr, lane); continue; }
        r -= 1024;
        if (r < 256) { const int nb = r % 32, kb = r / 32;
            conv_tile(a.in[9] + (size_t)l * 512 * 1024, 1024, 512, 32 * nb + pl, nullptr, (bf16_t*)(wbytes + W_PA), 32 * nb, 64 * kb, scr, lane); continue; }
        r -= 256;
        if (r < 512) { const int nb = r % 32, kb = r / 32;
            conv_tile(a.in[10] + (size_t)l * 1024 * 1024, 1024, 1024, 32 * nb + pl, nullptr, (bf16_t*)(wbytes + W_PB), 32 * nb, 64 * kb, scr, lane); continue; }
        r -= 512;
        if (r < 512) { const int nb = r % 32, kb = r / 32;
            conv_tile(a.in[11] + (size_t)l * 1024 * 1024, 1024, 1024, 32 * nb + pl, nullptr, (bf16_t*)(wbytes + W_OUT), 32 * nb, 64 * kb, scr, lane); continue; }
        r -= 512;
        if (r < 2816) { const int nb = r % 176, kb = r / 176, p = 32 * nb + pl, t = p >> 8, c = p & 255;
            const float* src = (c < 128 ? a.in[13] : a.in[14]) + (size_t)l * 1024 * 2816;
            conv_tile(src, 2816, 1024, 128 * t + (c & 127), n2, (bf16_t*)(wbytes + W_GU), 32 * nb, 64 * kb, scr, lane); continue; }
        r -= 2816;
        { const int nb = r % 32, kb = r / 32;
            conv_tile(a.in[15] + (size_t)l * 2816 * 1024, 1024, 2816, 32 * nb + pl, nullptr, (bf16_t*)(wbytes + W_D), 32 * nb, 64 * kb, scr, lane); }
    }
}

struct AttnU { int b, h, g, d, r, nb, jstart; };
DI AttnU attn_decode(int idx) { AttnU u; const int rem = idx % 192, uu = rem & 15; u.b = idx / 192; u.h = rem / 48; u.g = (rem % 48) >> 4; const int sh = 2 * u.g; u.d = 1 << sh; u.r = uu & (u.d - 1); u.nb = uu >> sh; u.jstart = (u.nb == 0) ? 128 : 0; return u; }
DI void attn_phase(LAS unsigned char* lds, const bf16_t* bufA, bf16_t* OG, float* DEN, int bid, int G) {
    int tid_raw = threadIdx.x; asm volatile("" : "+v"(tid_raw));
    const int tid = tid_raw, lane = tid & 63, w = __builtin_amdgcn_readfirstlane(tid >> 6), l31 = lane & 31, h2 = lane >> 5;
    const int qt = w >> 1, dbase = 2 * (w & 1), q4 = (lane & 15) >> 2, p4 = lane & 3, blk = (lane >> 4) & 1;
    LAS unsigned char* Ks = lds; LAS unsigned char* Vs = lds + 65536;
    const int per = (3072 + G - 1) / G, u0 = bid * per, u1 = (u0 + per < 3072) ? u0 + per : 3072;
    u32x4 kreg[8], vreg[8];
#define ATTN_ISSUE(U) do { _Pragma("unroll") for (int it = 0; it < 8; ++it) { const int e = tid + 512 * it, j = e >> 4, ch = e & 15; \
        if (j >= (U).jstart) { const int tk = (((U).nb - 1) * 128 + j) * (U).d + (U).r; const bf16_t* src = bufA + ((size_t)(U).b * SEQ + tk) * 2560 + (U).h * 128 + ch * 8; \
            kreg[it] = *(const u32x4*)(src + 1536); vreg[it] = *(const u32x4*)(src + 2048); } } } while (0)
    if (u0 < u1) { const AttnU un = attn_decode(u0); ATTN_ISSUE(un); }
    for (int idx = u0; idx < u1; ++idx) {
        const AttnU cu = attn_decode(idx);
        const int b = cu.b, h = cu.h, g = cu.g, d = cu.d, r = cu.r, nb = cu.nb, jstart = cu.jstart;
        const size_t rowb = (size_t)b * SEQ;
        const int iq = 32 * qt + l31, tq = (nb * 128 + iq) * d + r;
        const bf16_t* qp = bufA + (rowb + tq) * 2560 + (g * 4 + h) * 128 + 8 * h2;
        bf16x8 qf[8];
#pragma unroll
        for (int ks = 0; ks < 8; ++ks) qf[ks] = *(const bf16x8*)(qp + 16 * ks);
        __syncthreads();
#pragma unroll
        for (int it = 0; it < 8; ++it) { const int e = tid + 512 * it, j = e >> 4, ch = e & 15;
            if (j >= jstart) { const int o = 256 * j + 16 * (ch ^ (j & 15)); *(LAS u32x4*)(Ks + o) = kreg[it]; *(LAS u32x4*)(Vs + o) = vreg[it]; } }
        __syncthreads();
        if (idx + 1 < u1) { const AttnU un = attn_decode(idx + 1); ATTN_ISSUE(un); }
        f32x16 o0 = {}, o1 = {}; float den = 0.f;
        const int kb0 = (jstart >> 5) > qt ? (jstart >> 5) : qt;
        for (int kb = kb0; kb <= qt + 4; ++kb) {
            f32x16 s = zero16();
            const int key = 32 * kb + l31, sw = key & 15; const LAS unsigned char* kr = Ks + 256 * key;
#pragma unroll
            for (int ks = 0; ks < 8; ++ks) { const bf16x8 av = *(const LAS bf16x8*)(kr + 16 * ((2 * ks + h2) ^ sw)); s = MFMA32(av, qf[ks], s); }
            bf16x8 vfr[2][2];
#pragma unroll
            for (int s2 = 0; s2 < 2; ++s2) { const int key0 = 32 * kb + 16 * s2 + 4 * h2 + q4, key1 = key0 + 8;
#pragma unroll
                for (int dbi = 0; dbi < 2; ++dbi) { const int chunk = 4 * (dbase + dbi) + 2 * blk + (p4 >> 1);
                    const s16x4 lo = vtr(Vs + 256 * key0 + 16 * (chunk ^ (key0 & 15)) + 8 * (p4 & 1));
                    const s16x4 hi = vtr(Vs + 256 * key1 + 16 * (chunk ^ (key1 & 15)) + 8 * (p4 & 1)); vfr[s2][dbi] = cat8(lo, hi); } }
            const bool interior = (kb > qt) && (kb < qt + 4);
            if (interior) {
#pragma unroll
                for (int reg = 0; reg < 16; ++reg) { const float p = __builtin_amdgcn_exp2f(s[reg]); s[reg] = p; den += p; }
            } else {
#pragma unroll
                for (int reg = 0; reg < 16; ++reg) { const int j = 32 * kb + crow(reg, h2); const bool ok = (j >= iq) && (j <= iq + 128);
                    const float p = ok ? __builtin_amdgcn_exp2f(s[reg]) : 0.f; s[reg] = p; den += p; }
            }
#pragma unroll
            for (int s2 = 0; s2 < 2; ++s2) { const bf16x8 pb = pack8(s, s2);
                o0 = MFMA32(vfr[s2][0], pb, o0); o1 = MFMA32(vfr[s2][1], pb, o1); }
        }
        den += __shfl_xor(den, 32);
        bf16_t* op = OG + (size_t)g * T * 512 + (rowb + tq) * 512 + h * 128 + 4 * h2;
#pragma unroll
        for (int rg = 0; rg < 4; ++rg) {
            u32x2 v0; v0.x = pk2(o0[4 * rg], o0[4 * rg + 1]); v0.y = pk2(o0[4 * rg + 2], o0[4 * rg + 3]); *(u32x2*)(op + 32 * dbase + 8 * rg) = v0;
            u32x2 v1; v1.x = pk2(o1[4 * rg], o1[4 * rg + 1]); v1.y = pk2(o1[4 * rg + 2], o1[4 * rg + 3]); *(u32x2*)(op + 32 * (dbase + 1) + 8 * rg) = v1; }
        if ((w & 1) == 0 && h2 == 0) DEN[(rowb + tq) * 12 + h * 3 + g] = den;
    }
#undef ATTN_ISSUE
}
DI void ab_task(const bf16_t* xb, const bf16_t* wabT, const float* rowss, float* ABUF, int bid, int G) {
    int t = threadIdx.x; asm volatile("" : "+v"(t));
    const int lane = t & 63, w = __builtin_amdgcn_readfirstlane(t >> 6), li = lane & 15, lg = lane >> 4;
    for (int blk = bid * 8 + w; blk < T / 16; blk += G * 8) {
        const int row0 = blk * 16;
        const bf16_t* ap = xb + (size_t)(row0 + li) * 1024 + 8 * lg; const bf16_t* bp = wabT + (size_t)li * 1024 + 8 * lg;
        f32x4 acc = {0.f, 0.f, 0.f, 0.f};
#pragma unroll 16
        for (int c = 0; c < 32; ++c) acc = __builtin_amdgcn_mfma_f32_16x16x32_bf16(*(const bf16x8*)(ap + 32 * c), *(const bf16x8*)(bp + 32 * c), acc, 0, 0, 0);
#pragma unroll
        for (int e = 0; e < 4; ++e) { const int row = row0 + 4 * lg + e; ABUF[(size_t)row * 16 + li] = acc[e] * rowscale(rowss, row); }
    }
}
DI void combine_pass(bf16_t* OG, const float* DEN, int hid, int HN) {
    const size_t n8 = (size_t)T * 64, G1 = (size_t)T * 512;
    int tid_raw = threadIdx.x; asm volatile("" : "+v"(tid_raw));
    for (size_t i = (size_t)hid * 512 + tid_raw; i < n8; i += (size_t)HN * 512) { const size_t t = i >> 6; const int h = (int)(i & 63) >> 4;
        const float* dp = DEN + t * 12 + h * 3; const float inv = 1.f / (dp[0] + dp[1] + dp[2]);
        f32x4 a0, b0, a1, b1, a2, b2; unpk8(*(const u32x4*)(OG + i * 8), a0, b0); unpk8(*(const u32x4*)(OG + G1 + i * 8), a1, b1); unpk8(*(const u32x4*)(OG + 2 * G1 + i * 8), a2, b2);
        *(u32x4*)(OG + i * 8) = pk8((a0 + a1 + a2) * inv, (b0 + b1 + b2) * inv); }
}


DI u32x4 ld16_agent(const void* p) { const unsigned long long* q = (const unsigned long long*)p;
    const unsigned long long a = __hip_atomic_load(q, __ATOMIC_RELAXED, __HIP_MEMORY_SCOPE_AGENT), b = __hip_atomic_load(q + 1, __ATOMIC_RELAXED, __HIP_MEMORY_SCOPE_AGENT);
    return (u32x4){(unsigned)a, (unsigned)(a >> 32), (unsigned)b, (unsigned)(b >> 32)}; }
DI unsigned ld2_agent(const bf16_t* p) { return (unsigned)__hip_atomic_load(p, __ATOMIC_RELAXED, __HIP_MEMORY_SCOPE_AGENT); }
constexpr int G_QT = 0, G_KT = 16384, G_VT = 32768, G_OST = 65536, G_ABS = 98304, G_SEG = 102400, G_BL = 104448, G_GN = 104960, G_WU = 105984;
constexpr int GLA_UNITS = 64 * 32;
DI void gla1_phase(LAS unsigned char* lds, bf16_t* bufB, const float* ABUF, const float* wup, const float* ba, float* BLG, int bid, int G) {
    int tid_raw = threadIdx.x; asm volatile("" : "+v"(tid_raw));
#define GLA_IDS() int tid = tid_raw; asm volatile("" : "+v"(tid)); const int lane = tid & 63, l31 = lane & 31, h2 = lane >> 5, q4 = (lane & 15) >> 2, p4 = lane & 3, blk = (lane >> 4) & 1, dch = tid & 127, seg = tid >> 7; (void)l31; (void)h2; (void)q4; (void)p4; (void)blk; (void)dch; (void)seg
    LAS unsigned char* QT = lds + G_QT; LAS unsigned char* KT = lds + G_KT; LAS unsigned char* OST = lds + G_OST;
    LAS float* ABS = (LAS float*)(lds + G_ABS); LAS float* SEG = (LAS float*)(lds + G_SEG); LAS float* WU = (LAS float*)(lds + G_WU);
    int hprev = -1;
    f32x2 p_ab = {0.f, 0.f}; u32x4 p_q[2], p_k[2];
#define GLA1_ISSUE(UN) do { int t_ = tid_raw; asm volatile("" : "+v"(t_)); const int st_ = (UN) >> 5, c_ = (UN) & 31, b_ = st_ >> 2, h_ = st_ & 3; const size_t tk_ = (size_t)b_ * SEQ + c_ * 64; \
        p_ab = *(const f32x2*)(ABUF + tk_ * 16 + 2 * t_); \
        _Pragma("unroll") for (int i = 0; i < 2; ++i) { const int e = t_ + 512 * i, row = e >> 4, ch = e & 15; const bf16_t* src = bufB + (tk_ + row) * 2048 + h_ * 128 + ch * 8; p_q[i] = *(const u32x4*)src; p_k[i] = *(const u32x4*)(src + 512); } } while (0)
    if (bid < GLA_UNITS) GLA1_ISSUE(bid);
#pragma nounroll
    for (int unit = bid; unit < GLA_UNITS; unit += G) {
        const int st = unit >> 5, c = unit & 31, b = st >> 2, h = st & 3;
        const size_t tok0 = (size_t)b * SEQ + c * 64;
        __syncthreads();
        if (h != hprev) { GLA_IDS(); hprev = h;
            if (tid < 128) {
#pragma unroll
                for (int r = 0; r < 16; ++r) WU[r * 128 + tid] = wup[r * 512 + h * 128 + tid];
                WU[16 * 128 + tid] = ba[h * 128 + tid]; } }
        { GLA_IDS();
        *(LAS f32x2*)(ABS + 2 * tid) = p_ab;
#pragma unroll
        for (int i = 0; i < 2; ++i) { const int e = tid + 512 * i, row = e >> 4, ch = e & 15; *(LAS u32x4*)(OST + 256 * row + 16 * ch) = p_q[i]; *(LAS u32x4*)(OST + 16384 + 256 * row + 16 * ch) = p_k[i]; }
        __syncthreads();
        if (unit + G < GLA_UNITS) GLA1_ISSUE(unit + G);
        unsigned qk[16];
#pragma unroll
        for (int i = 0; i < 16; ++i) { const int o2 = 256 * (16 * seg + i) + 2 * dch; qk[i] = (unsigned)*(const LAS unsigned short*)(OST + o2) | ((unsigned)*(const LAS unsigned short*)(OST + 16384 + o2) << 16); }
        float cum[16]; float run = 0.f; float zz[16];
#pragma unroll
        for (int i = 0; i < 16; ++i) zz[i] = WU[16 * 128 + dch];
#pragma unroll
        for (int r4 = 0; r4 < 4; ++r4) { const float w0 = WU[(4 * r4) * 128 + dch], w1 = WU[(4 * r4 + 1) * 128 + dch], w2 = WU[(4 * r4 + 2) * 128 + dch], w3 = WU[(4 * r4 + 3) * 128 + dch];
#pragma unroll
            for (int i = 0; i < 16; ++i) { const f32x4 av = *(const LAS f32x4*)(ABS + (16 * seg + i) * 16 + 4 * r4); zz[i] += (av[0] * w0 + av[1] * w1) + (av[2] * w2 + av[3] * w3); } }
#pragma unroll
        for (int i = 0; i < 16; ++i) { const float z = zz[i];
            const float la = (fminf(z, 0.f) - __logf(1.f + __expf(-fabsf(z)))) * 0.0625f; run += la; cum[i] = run; }
        SEG[seg * 128 + dch] = run;
        __syncthreads();
        float pre = 0.f, tot = 0.f;
#pragma unroll
        for (int s_ = 0; s_ < 4; ++s_) { const float v = SEG[s_ * 128 + dch]; tot += v; if (s_ < seg) pre += v; }
#pragma unroll
        for (int i = 0; i < 16; ++i) { const int t = 16 * seg + i; const float bi = pre + cum[i]; const float eb = __expf(bi), ebi = __builtin_amdgcn_rcpf(eb);
            const float qv = __uint_as_float(qk[i] << 16), kv = __uint_as_float(qk[i] & 0xffff0000u);
            const int o = 256 * t + 16 * ((dch >> 3) ^ (t & 15)) + 2 * (dch & 7);
            const unsigned me = pk2(qv * eb, kv * ebi), nb = (unsigned)__shfl_xor((int)me, 1);
            if (!(dch & 1)) { *(LAS unsigned*)(QT + o) = (me & 0xffffu) | (nb << 16); *(LAS unsigned*)(KT + o) = (me >> 16) | (nb & 0xffff0000u); } }
        if (seg == 3) BLG[(size_t)unit * 128 + dch] = __expf(tot);
        __syncthreads();
#pragma unroll
        for (int i = 0; i < 2; ++i) { const int e = tid + 512 * i, row = e >> 4, ch = e & 15; bf16_t* dst = bufB + (tok0 + row) * 2048 + h * 128 + ch * 8;
            *(u32x4*)dst = *(const LAS u32x4*)(QT + 256 * row + 16 * ch); *(u32x4*)(dst + 512) = *(const LAS u32x4*)(KT + 256 * row + 16 * ch); } }
    }
#undef GLA1_ISSUE
#undef GLA_IDS
}
DI void gla2_phase(LAS unsigned char* lds, const bf16_t* bufB, bf16_t* RB, const float* BLG, const float* gn, int bid, int G) {
    int tid_raw = threadIdx.x; asm volatile("" : "+v"(tid_raw));
    const int w = __builtin_amdgcn_readfirstlane(tid_raw >> 6);
#define GLA_IDS() int tid = tid_raw; asm volatile("" : "+v"(tid)); const int lane = tid & 63, l31 = lane & 31, h2 = lane >> 5, q4 = (lane & 15) >> 2, p4 = lane & 3, blk = (lane >> 4) & 1; (void)l31; (void)h2; (void)q4; (void)p4; (void)blk
    LAS unsigned char* QT = lds + G_QT; LAS unsigned char* KT = lds + G_KT; LAS unsigned char* VT = lds + G_VT; LAS unsigned char* OST = lds + G_OST;
    LAS float* BL = (LAS float*)(lds + G_BL); LAS float* GN = (LAS float*)(lds + G_GN);
    for (int st = bid; st < 64; st += G) {
        const int b = st >> 2, h = st & 3;
        __syncthreads();
        { GLA_IDS(); if (tid < 256) GN[tid] = gn[tid]; }
        f32x16 S[4];
#pragma unroll
        for (int i = 0; i < 4; ++i) S[i] = (f32x16){};
        u32x4 pq[2], pk[2], pv[4]; float pa = 0.f;
        { GLA_IDS(); const size_t tok0 = (size_t)b * SEQ;
#pragma unroll
            for (int i = 0; i < 2; ++i) { const int e = tid + 512 * i, row = e >> 4, ch = e & 15; const bf16_t* src = bufB + (tok0 + row) * 2048 + h * 128 + ch * 8; pq[i] = *(const u32x4*)src; pk[i] = *(const u32x4*)(src + 512); }
#pragma unroll
            for (int i = 0; i < 4; ++i) { const int e = tid + 512 * i, row = e >> 5, ch = e & 31; pv[i] = *(const u32x4*)(bufB + (tok0 + row) * 2048 + 1024 + h * 256 + ch * 8); }
            if (tid < 128) pa = BLG[(size_t)(st * 32) * 128 + tid]; }
#pragma nounroll
        for (int c = 0; c < 32; ++c) {
            const size_t tok0 = (size_t)b * SEQ + c * 64;
            u32x4 gate[4];
            { GLA_IDS();
#pragma unroll
            for (int i = 0; i < 2; ++i) { const int e = tid + 512 * i, row = e >> 4, ch = e & 15; *(LAS u32x4*)(QT + 256 * row + 16 * ch) = pq[i]; *(LAS u32x4*)(KT + 256 * row + 16 * ch) = pk[i]; }
#pragma unroll
            for (int i = 0; i < 4; ++i) { const int e = tid + 512 * i, row = e >> 5, ch = e & 31; *(LAS u32x4*)(VT + 512 * row + 16 * (ch ^ (row & 15))) = pv[i]; }
            if (tid < 128) BL[tid] = pa;
            __syncthreads();
            if (c + 1 < 32) { const size_t tn = tok0 + 64;
#pragma unroll
                for (int i = 0; i < 2; ++i) { const int e = tid + 512 * i, row = e >> 4, ch = e & 15; const bf16_t* src = bufB + (tn + row) * 2048 + h * 128 + ch * 8; pq[i] = *(const u32x4*)src; pk[i] = *(const u32x4*)(src + 512); }
#pragma unroll
                for (int i = 0; i < 4; ++i) { const int e = tid + 512 * i, row = e >> 5, ch = e & 31; pv[i] = *(const u32x4*)(bufB + (tn + row) * 2048 + 1024 + h * 256 + ch * 8); }
                if (tid < 128) pa = BLG[(size_t)(st * 32 + c + 1) * 128 + tid]; }
            bf16x8 vf[4];
#pragma unroll
            for (int k4 = 0; k4 < 4; ++k4) { const int row0 = 16 * k4 + 4 * h2 + q4, row1 = row0 + 8, chunk = 4 * w + 2 * blk + (p4 >> 1);
                const s16x4 lo = vtr(VT + 512 * row0 + 16 * (chunk ^ (row0 & 15)) + 8 * (p4 & 1));
                const s16x4 hi = vtr(VT + 512 * row1 + 16 * (chunk ^ (row1 & 15)) + 8 * (p4 & 1)); vf[k4] = cat8(lo, hi); }
#pragma unroll
            for (int tb = 0; tb < 2; ++tb) {
                f32x16 acc = zero16();
                const int t = 32 * tb + l31, tsw = t & 15; const LAS unsigned char* qrow = QT + 256 * t;
#pragma unroll
                for (int dkb = 0; dkb < 4; ++dkb) { const bf16x8 sf0 = pack8(S[dkb], 0), sf1 = pack8(S[dkb], 1);
#pragma unroll
                    for (int ks = 0; ks < 2; ++ks) { const int ch0 = 4 * dkb + 2 * ks;
                        const s16x4 lo = *(const LAS s16x4*)(qrow + 16 * (ch0 ^ tsw) + 8 * h2), hi = *(const LAS s16x4*)(qrow + 16 * ((ch0 + 1) ^ tsw) + 8 * h2);
                        acc = MFMA32(cat8(lo, hi), ks == 0 ? sf0 : sf1, acc); } }
#pragma unroll
                for (int sb = 0; sb <= tb; ++sb) { f32x16 X = zero16(); const int srow = 32 * sb + l31, ssw = srow & 15; const LAS unsigned char* krow_ = KT + 256 * srow;
#pragma unroll
                    for (int ks = 0; ks < 8; ++ks) { const bf16x8 av = *(const LAS bf16x8*)(krow_ + 16 * ((2 * ks + h2) ^ ssw)), bv = *(const LAS bf16x8*)(qrow + 16 * ((2 * ks + h2) ^ tsw)); X = MFMA32(av, bv, X); }
                    if (sb == tb) {
#pragma unroll
                        for (int reg = 0; reg < 16; ++reg) if (crow(reg, h2) > l31) X[reg] = 0.f; }
                    acc = MFMA32(pack8(X, 0), vf[2 * sb], acc); acc = MFMA32(pack8(X, 1), vf[2 * sb + 1], acc); }
#pragma unroll
                for (int reg = 0; reg < 16; ++reg) *(LAS unsigned short*)(OST + 512 * (32 * tb + crow(reg, h2)) + 2 * (32 * w + l31)) = (unsigned short)pk2(acc[reg], 0.f);
            }
            { const int t = tid >> 3, s8 = tid & 7; const bf16_t* rp = RB + (tok0 + t) * 1024 + h * 256 + 32 * s8;
#pragma unroll
                for (int i = 0; i < 4; ++i) gate[i] = *(const u32x4*)(rp + 8 * i); }
#pragma unroll
            for (int dkb = 0; dkb < 4; ++dkb) {
#pragma unroll
                for (int k4 = 0; k4 < 4; ++k4) { const int key0 = 16 * k4 + 4 * h2 + q4, key1 = key0 + 8, chunk = 4 * dkb + 2 * blk + (p4 >> 1);
                    const s16x4 lo = vtr(KT + 256 * key0 + 16 * (chunk ^ (key0 & 15)) + 8 * (p4 & 1));
                    const s16x4 hi = vtr(KT + 256 * key1 + 16 * (chunk ^ (key1 & 15)) + 8 * (p4 & 1));
                    S[dkb] = MFMA32(cat8(lo, hi), vf[k4], S[dkb]); }
#pragma unroll
                for (int rg = 0; rg < 4; ++rg) { const f32x4 dv = *(const LAS f32x4*)(BL + 32 * dkb + 8 * rg + 4 * h2);
                    S[dkb][4 * rg] *= dv[0]; S[dkb][4 * rg + 1] *= dv[1]; S[dkb][4 * rg + 2] *= dv[2]; S[dkb][4 * rg + 3] *= dv[3]; }
            }
            }
            __syncthreads();
            { GLA_IDS(); const int t = tid >> 3, s8 = tid & 7; const LAS u32x4* orow = (const LAS u32x4*)(OST + 512 * t + 64 * s8);
                f32x4 ov[8]; float ss = 0.f;
#pragma unroll
                for (int i = 0; i < 4; ++i) { unpk8(orow[i], ov[2 * i], ov[2 * i + 1]); }
#pragma unroll
                for (int i = 0; i < 8; ++i) ss += (ov[i][0] * ov[i][0] + ov[i][1] * ov[i][1]) + (ov[i][2] * ov[i][2] + ov[i][3] * ov[i][3]);
                ss += __shfl_xor(ss, 1); ss += __shfl_xor(ss, 2); ss += __shfl_xor(ss, 4);
                const float rn = rsqrtf(ss * (1.f / 256.f) + EPS);
                bf16_t* rp = RB + (tok0 + t) * 1024 + h * 256 + 32 * s8;
#pragma unroll
                for (int i = 0; i < 4; ++i) { f32x4 ra, rb2; unpk8(gate[i], ra, rb2);
                    const f32x4 g0 = *(const LAS f32x4*)(GN + 32 * s8 + 8 * i), g1 = *(const LAS f32x4*)(GN + 32 * s8 + 8 * i + 4);
                    *(u32x4*)(rp + 8 * i) = pk8(ov[2 * i] * rn * g0 * ra, ov[2 * i + 1] * rn * g1 * rb2); } }
        }
    }
#undef GLA_IDS
}
#define XB_TMO      128
#define XB_XCNT(j)  (256  + 64 * (j))
#define XB_XSUB(j)  (1280 + 64 * (j))
#define XB_XGEN(j)  (2304 + 64 * (j))
#define XB_TOP      3328
#define XB_TOPGEN   3392
#define XCD_BAR_WORDS 3456
#define XB_SPIN_CAP (1u << 18)

__device__ __forceinline__ unsigned xb_ld(unsigned* p)              { return __hip_atomic_load(p, __ATOMIC_RELAXED, __HIP_MEMORY_SCOPE_AGENT); }
__device__ __forceinline__ unsigned xb_add(unsigned* p, unsigned v) { return __hip_atomic_fetch_add(p, v, __ATOMIC_RELAXED, __HIP_MEMORY_SCOPE_AGENT); }
__device__ __forceinline__ unsigned xb_xcc_id() { return (unsigned)__builtin_amdgcn_s_getreg((3 << 11) | 20) & 0xFu; }
#define XB_SPIN(cond, bar) do { unsigned _sp = 0; while (cond) { __builtin_amdgcn_s_sleep(1); \
    if ((++_sp & 255u) == 0u) { if (xb_ld(&(bar)[XB_TMO])) break; if (_sp > XB_SPIN_CAP) { atomicAdd(&(bar)[XB_TMO], 1u); break; } } } } while (0)

struct XcdBarrier {
    unsigned* bar; unsigned x;
    volatile LAS unsigned* st;
};

__device__ __forceinline__ XcdBarrier xcd_barrier_post(unsigned* bar, volatile LAS unsigned* st) {
    XcdBarrier b; b.bar = bar; b.x = xb_xcc_id(); b.st = st;
    if (threadIdx.x == 0) (void)xb_add(&bar[XB_XCNT(b.x)], 1u);
    return b;
}
__device__ __forceinline__ void xcd_barrier_complete(unsigned* bar, unsigned x, unsigned& nloc, unsigned& nx) {
    const unsigned G = gridDim.x * gridDim.y * gridDim.z;
    unsigned sum, cnt, mine, sp = 0u;
    for (;;) {
        sum = 0u; cnt = 0u; mine = 0u;
#pragma unroll
        for (unsigned j = 0; j < 16; ++j) { const unsigned c = xb_ld(&bar[XB_XCNT(j)]); sum += c; cnt += (c > 0u) ? 1u : 0u; mine = (j == x) ? c : mine; }
        if (sum == G) break;
        __builtin_amdgcn_s_sleep(1);
        if ((++sp & 255u) == 0u) { if (xb_ld(&bar[XB_TMO])) break; if (sp > XB_SPIN_CAP) { atomicAdd(&bar[XB_TMO], 1u); break; } }
    }
    nloc = mine > 0u ? mine : 1u; nx = cnt > 0u ? cnt : 1u;
}

__device__ __forceinline__ void xcd_barrier(const XcdBarrier& b) {
    asm volatile("s_waitcnt vmcnt(0)" ::: "memory");
    __syncthreads();
    if (threadIdx.x == 0) {
        unsigned* bar = b.bar;
        __builtin_amdgcn_s_waitcnt(0);
        unsigned nloc = b.st[0], nx = b.st[1];
        if (nloc == 0u) { xcd_barrier_complete(bar, b.x, nloc, nx); b.st[0] = nloc; b.st[1] = nx; }
        const unsigned old = xb_add(&bar[XB_XSUB(b.x)], 1u);
        const unsigned gen = old / nloc;
        if (old + 1u == (gen + 1u) * nloc) {
            __builtin_amdgcn_fence(__ATOMIC_RELEASE, "agent");
            asm volatile("s_waitcnt vmcnt(0)" ::: "memory");
            const unsigned og = xb_add(&bar[XB_TOP], 1u);
            const unsigned tg = og / nx;
            if (og + 1u == (tg + 1u) * nx) xb_add(&bar[XB_TOPGEN], 1u);
            else XB_SPIN(xb_ld(&bar[XB_TOPGEN]) == tg, bar);
            __builtin_amdgcn_fence(__ATOMIC_ACQUIRE, "agent");
            xb_add(&bar[XB_XGEN(b.x)], 1u);
            asm volatile("s_waitcnt vmcnt(0)" ::: "memory");
        } else {
            XB_SPIN(xb_ld(&bar[XB_XGEN(b.x)]) == gen, bar);
            __builtin_amdgcn_fence(__ATOMIC_ACQUIRE, "agent");
            asm volatile("s_waitcnt vmcnt(0)" ::: "memory");
        }
    }
    __syncthreads();
}

__global__ void __launch_bounds__(512, 2) hybrid_fwd(Args a) {
    extern __shared__ __attribute__((aligned(16))) unsigned char lds_raw[];
    LAS unsigned char* lds = (LAS unsigned char*)lds_raw;
    cg::grid_group grid = cg::this_grid();
#define GRID_SYNC_CG() do { asm volatile("s_waitcnt vmcnt(0)" ::: "memory"); grid.sync(); asm volatile("s_waitcnt vmcnt(0)" ::: "memory"); __builtin_amdgcn_s_barrier(); asm volatile("" ::: "memory"); } while (0)
#define GRID_SYNC() xcd_barrier(xbar)
    const int wave = __builtin_amdgcn_readfirstlane((int)threadIdx.x >> 6);
    const int bid = blockIdx.x, G = gridDim.x;
    volatile LAS unsigned* xst = (volatile LAS unsigned*)(lds + LDS_BYTES - 64);
    if (threadIdx.x < 2) xst[threadIdx.x] = 0u;
    __syncthreads();
    const XcdBarrier xbar = xcd_barrier_post((unsigned*)(a.ws + WS_BAR), xst);
    unsigned char* ws = a.ws;
#define XB ((bf16_t*)(ws + WS_XB))
#define OG ((bf16_t*)(ws + WS_R + R_OG))
#define BUFA ((bf16_t*)(ws + WS_R + R_BUFA))
#define BUFB ((bf16_t*)(ws + WS_R + R_BUFB))
#define RBB ((bf16_t*)(ws + WS_R + R_RB))
#define GA8 ((unsigned char*)(ws + WS_R + R_GA))
#define GB8 ((unsigned char*)(ws + WS_R + R_GA + 32 * MiB))
#define YB ((bf16_t*)(ws + WS_GB))
#define HB ((bf16_t*)(ws + WS_R + R_HB))
#define ROPE ((float*)(ws + WS_ROPE))
#define ABUF ((float*)(ws + WS_AB))
#define DEN ((float*)(ws + WS_DEN))
    float* xout = a.out;
    LAS float* cscr = (LAS float*)(lds + wave * 8704);

    {
        float* ROWSS = (float*)(ws + WS_ROWSS);
        int tid = threadIdx.x; asm volatile("" : "+v"(tid)); const int lane = tid & 63;
        const int gw = bid * 8 + wave, ngw = G * 8;
        conv_layer(a, 0, ws, cscr, gw, ngw);
        const float* x = a.in[0];
        for (int m = gw; m < T; m += ngw) { const f32x4* xr = (const f32x4*)(x + (size_t)m * 1024) + lane; float s = 0.f; u32x2* o8 = (u32x2*)(XB + (size_t)m * 1024) + lane;
#pragma unroll
            for (int j = 0; j < 4; ++j) { const f32x4 v = xr[64 * j]; s += (v[0] * v[0] + v[1] * v[1]) + (v[2] * v[2] + v[3] * v[3]); u32x2 o; o.x = pk2(v[0], v[1]); o.y = pk2(v[2], v[3]); o8[64 * j] = o; }
            s = wave_sum(s); if (lane < 16) ROWSS[(size_t)m * 16 + lane] = (lane == 0) ? s : 0.f; }
        const size_t gt = (size_t)bid * 512 + tid, ngt = (size_t)G * 512;
        const int* pos = (const int*)a.in[1];
        for (size_t i = gt; i < (size_t)T * 64; i += ngt) { const int t = (int)(i >> 6), f = (int)(i & 63);
            const float inv_freq = powf(10000.f, -(float)(2 * f) / 128.f); const float ang = (float)pos[t] * inv_freq;
            double rev = (double)ang * 0.15915494309189535; rev -= floor(rev); const float fr = (float)rev;
            typedef _Float16 h2_t __attribute__((ext_vector_type(2))); const h2_t hv = {(_Float16)__builtin_amdgcn_cosf(fr), (_Float16)__builtin_amdgcn_sinf(fr)};
            ((unsigned*)ROPE)[i] = __builtin_bit_cast(unsigned, hv); }
    }
    GRID_SYNC_CG();

    for (int l0 = 0; l0 < DEPTH; ++l0) {
#define PHASE_PTRS() int l = l0; asm volatile("" : "+s"(l)); unsigned char* wb = ws + (size_t)(l & 1) * W_LAYER; float* ROWSS = (float*)(ws + WS_ROWSS); \
        const float* ss1 = ROWSS; float* ss2 = ROWSS + (size_t)T * 16; float* ss1n = ROWSS; (void)wb; (void)ss1; (void)ss2; (void)ss1n
        { PHASE_PTRS(); Gemm g{XB, (const bf16_t*)(wb + W_INA), T, 2560, 1024}; StaticOrder S; S.init(T, 2560, G, bid);
          EpiInA E{BUFA, ss1, a.in[4] + l * 128, a.in[5] + l * 128, ROPE, (LAS float*)(lds + EPI_LDS), QSCALE};
#ifndef NO_G1
          gemm_phase<EpiInA, StaticOrder, true, true>(lds, g, S, E);
#endif
        }
        GRID_SYNC();
#ifndef NO_ATTN
        attn_phase(lds, (const bf16_t*)(ws + WS_R + R_BUFA), (bf16_t*)(ws + WS_R + R_OG), (float*)(ws + WS_DEN), (G % 8 == 0) ? (bid % 8) * (G / 8) + bid / 8 : bid, G);
#endif
        GRID_SYNC();
        { PHASE_PTRS(); ab_task(XB, (const bf16_t*)(wb + W_INB) + (size_t)3072 * 1024, ss1, ABUF, bid, G);
          Gemm g{XB, (const bf16_t*)(wb + W_INB), T, 3072, 1024}; StaticOrder S; S.init(T, 3072, G, bid);
          EpiInB E{BUFB, RBB, ABUF, ss1, (LAS float*)(lds + EPI_LDS) + 2048};
#ifndef NO_G2
          gemm_phase<EpiInB, StaticOrder, true, true>(lds, g, S, E);
#endif
        }
        GRID_SYNC();
        { PHASE_PTRS();
          combine_pass(OG, DEN, bid, G);
#ifndef NO_GLA
          gla1_phase(lds, BUFB, ABUF, a.in[6] + (size_t)l * 16 * 512, a.in[7] + l * 512, (float*)(ws + WS_BLG), bid, G);
#endif
        }
        GRID_SYNC();
        { PHASE_PTRS();
#ifndef NO_GLA
        if (G <= 64 || bid < 64) gla2_phase(lds, BUFB, RBB, (const float*)(ws + WS_BLG), a.in[8] + l * 256, bid, G <= 64 ? G : 64);
#endif
        if (G <= 64 || bid >= 64) { const int hid = G <= 64 ? bid : bid - 64, HN = G <= 64 ? G : G - 64;
            __syncthreads();
            if (l + 1 < DEPTH) conv_layer(a, l + 1, ws + (size_t)((l + 1) & 1) * W_LAYER, cscr, hid * 8 + wave, HN * 8);
            __syncthreads();
            Gemm g{XB, (const bf16_t*)(wb + W_INC), T, 2048, 1024}; StaticOrder S; S.init(T, 2048, HN, hid);
            EpiInC E{GA8, GB8, ss1, (LAS float*)(lds + EPI_LDS) + 2048};
#ifndef NO_G3
            gemm_phase<EpiInC, StaticOrder, true, true>(lds, g, S, E);
#endif
        } }
        GRID_SYNC();
        { PHASE_PTRS(); Gemm g{OG, (const bf16_t*)(wb + W_PA), T, 1024, 512}; StaticOrder S; S.init(T, 1024, G, bid);
          EpiProj<0> E{YB, GA8};
#ifndef NO_G4
          gemm_phase<EpiProj<0>, StaticOrder, true, true>(lds, g, S, E);
#endif
        }
        { PHASE_PTRS(); Gemm g{RBB, (const bf16_t*)(wb + W_PB), T, 1024, 1024}; StaticOrder S; S.init(T, 1024, G, bid);
          EpiProj<1> E{YB, GB8};
#ifndef NO_G5
          gemm_phase<EpiProj<1>, StaticOrder, true, true>(lds, g, S, E);
#endif
        }
        GRID_SYNC();
        { PHASE_PTRS(); Gemm g{YB, (const bf16_t*)(wb + W_OUT), T, 1024, 1024}; StaticOrder S; S.init(T, 1024, G, bid);
          EpiRes E{l == 0 ? a.in[0] : xout, xout, XB, ss2, 0};
#ifndef NO_G6
          gemm_phase<EpiRes, StaticOrder, true, true>(lds, g, S, E);
#endif
        }
        GRID_SYNC();
        { PHASE_PTRS(); Gemm g{XB, (const bf16_t*)(wb + W_GU), T, 5632, 1024}; StaticOrder S; S.init(T, 5632, G, bid);
          EpiFFN E{HB, ss2, (LAS float*)(lds + EPI_LDS) + 2048};
#ifndef NO_G7
          gemm_phase<EpiFFN, StaticOrder, true, true>(lds, g, S, E);
#endif
        }
        GRID_SYNC();
        { PHASE_PTRS(); Gemm g{HB, (const bf16_t*)(wb + W_D), T, 1024, 2816}; StaticOrder S; S.init(T, 1024, G, bid);
          EpiRes E{xout, xout, XB, ss1n, l + 1 == DEPTH};
#ifndef NO_G8
          gemm_phase<EpiRes, StaticOrder, true, true>(lds, g, S, E);
#endif
        }
        if (l0 + 1 < DEPTH) GRID_SYNC();
    }
}

extern "C" void kernel_launch(void* const* d_in, const int* in_sizes, int n_in, void* d_out, int out_size, void* d_ws, size_t ws_size, hipStream_t stream) {
    static int grid = 0;
    if (grid == 0) {
        if (n_in != 16 || out_size != T * 1024 || ws_size < WS_END) { fprintf(stderr, "kernel_launch: unexpected shapes (n_in %d, out %d, ws %zu)\n", n_in, out_size, ws_size); grid = -1; return; }
        int dev = 0, cus = 0, per_cu = 0;
        hipGetDevice(&dev); hipDeviceGetAttribute(&cus, hipDeviceAttributeMultiprocessorCount, dev);
        hipFuncSetAttribute((const void*)hybrid_fwd, hipFuncAttributeMaxDynamicSharedMemorySize, LDS_BYTES);
        hipOccupancyMaxActiveBlocksPerMultiprocessor(&per_cu, (const void*)hybrid_fwd, 512, LDS_BYTES);
        if (per_cu < 1) per_cu = 1;
        (void)hipGetLastError();
        grid = cus * per_cu;
    }
    if (grid < 0) return;
    if (hipMemsetAsync((char*)d_ws + WS_BAR, 0, 16384, stream) != hipSuccess) { fprintf(stderr, "kernel_launch: memset of the barrier words failed\n"); return; }
    Args a{};
    for (int i = 0; i < 16; ++i) a.in[i] = (const float*)d_in[i];
    a.out = (float*)d_out; a.ws = (unsigned char*)d_ws;
    void* args[] = {&a};
    hipError_t e = hipLaunchCooperativeKernel((const void*)hybrid_fwd, dim3(grid), dim3(512), args, LDS_BYTES, stream);
    if (e != hipSuccess) fprintf(stderr, "cooperative launch failed: %s (grid %d)\n", hipGetErrorString(e), grid);
}
```

```cpp
#include <hip/hip_runtime.h>
#include <hip/hip_cooperative_groups.h>
#include <cstdio>
#include <cstdint>
namespace cg = cooperative_groups;

namespace pg8 {
#define PG8_LAS __attribute__((address_space(3)))
typedef unsigned short bf16_t;
typedef short bf16x8 __attribute__((ext_vector_type(8)));
typedef float f32x4 __attribute__((ext_vector_type(4)));
typedef unsigned u32x4 __attribute__((ext_vector_type(4)));
constexpr int BM = 256, BK = 64, HALF = 128, HTB = HALF * BK * 2  , STAGE_BYTES = 8 * HTB, NXCD = 8, WGM = 8;

__host__ __device__ __forceinline__ int lds_byte(int r, int c) { const int st = (r >> 4) * 2 + (c >> 5), rr = r & 15, cc = c & 31, ob = rr * 64 + cc * 2; return st * 1024 + (ob ^ (((ob >> 9) & 1) << 5)); }
__host__ __device__ __forceinline__ void stage_rc(int b, int& R, int& C) { const int st = b / 1024, sb = b % 1024, swz = sb ^ (((sb >> 9) & 1) << 5); R = (st >> 1) * 16 + swz / 64; C = (st & 1) * 32 + (swz % 64) / 2; }
__host__ __device__ __forceinline__ int perm32(int rho) { const int n = rho >> 4, i = rho & 15; return 8 * (i >> 2) + 4 * n + (i & 3); }

struct Unit { int pm, pn; };
struct Gemm { const bf16_t* A; const bf16_t* Bt; int M, N, K; };

struct StaticOrder {
    int nM, nN, nwg, G, c;
    __host__ __device__ void init(int M, int N, int G_, int c_) { nM = M / BM; nN = N / BM; nwg = nM * nN; G = G_; c = c_; }
    __host__ __device__ bool next(int i, Unit& u) const {
        const long L = (long)i * G + c; if (L >= nwg) return false;
        int wgid = (int)L; { const int q = nwg / NXCD, r = nwg % NXCD, xcd = wgid % NXCD, off = wgid / NXCD; wgid = (xcd < r ? xcd * (q + 1) : r * (q + 1) + (xcd - r) * q) + off; }
        const int nig = WGM * nN, gid = wgid / nig, fm = gid * WGM, gsz = (nM - fm) < WGM ? (nM - fm) : WGM;
        u.pm = fm + ((wgid % nig) % gsz); u.pn = (wgid % nig) / gsz; return true;
    }
    __device__ __forceinline__ void a_ready(const Unit&) const {}
    __device__ __forceinline__ void done(const Unit&) const {}
};

typedef unsigned u32x2 __attribute__((ext_vector_type(2)));
typedef float f32x2 __attribute__((ext_vector_type(2)));
typedef __bf16 bf16x2_t __attribute__((ext_vector_type(2)));
constexpr float EPS_ = 1e-6f;
constexpr int T_ = 32768;
__device__ __forceinline__ unsigned pk2(float lo, float hi) { f32x2 v = {lo, hi}; bf16x2_t b = __builtin_convertvector(v, bf16x2_t); return __builtin_bit_cast(unsigned, b); }
__device__ __forceinline__ u32x4 pk8(f32x4 a, f32x4 b) { u32x4 w; w.x = pk2(a[0], a[1]); w.y = pk2(a[2], a[3]); w.z = pk2(b[0], b[1]); w.w = pk2(b[2], b[3]); return w; }
__device__ __forceinline__ float bflo(unsigned w) { return __uint_as_float(w << 16); }
__device__ __forceinline__ float bfhi(unsigned w) { return __uint_as_float(w & 0xffff0000u); }
__device__ __forceinline__ void unpk8(u32x4 w, f32x4& a, f32x4& b) { a = (f32x4){bflo(w.x), bfhi(w.x), bflo(w.y), bfhi(w.y)}; b = (f32x4){bflo(w.z), bfhi(w.z), bflo(w.w), bfhi(w.w)}; }
__device__ __forceinline__ float sigm(float x) { return __builtin_amdgcn_rcpf(1.f + __expf(-x)); }
__device__ __forceinline__ f32x4 sigm4(f32x4 v) { return (f32x4){sigm(v[0]), sigm(v[1]), sigm(v[2]), sigm(v[3])}; }
__device__ __forceinline__ f32x4 silu4(f32x4 v) { return v * sigm4(v); }
__device__ __forceinline__ float rowscale(const float* rowss, int row) { const f32x4* p = (const f32x4*)(rowss + (size_t)row * 16); const f32x4 a = p[0], b = p[1], c = p[2], d = p[3];
    const float s = (((a[0] + a[1]) + (a[2] + a[3])) + ((b[0] + b[1]) + (b[2] + b[3]))) + (((c[0] + c[1]) + (c[2] + c[3])) + ((d[0] + d[1]) + (d[2] + d[3])));
    return rsqrtf(s * (1.f / 1024.f) + EPS_); }
__device__ __forceinline__ void stage_rowscale(PG8_LAS float* RS, const float* rowss, int pm) {
    int t = threadIdx.x; asm volatile("" : "+v"(t));
    if (t < 256) RS[t] = rowscale(rowss, pm * 256 + t);
    asm volatile("s_waitcnt lgkmcnt(0)" ::: "memory"); __builtin_amdgcn_s_barrier(); asm volatile("" ::: "memory");
}
#define EPI_ROWS(ai, m) _Pragma("unroll") for (int ai = 0; ai < 2; ++ai) _Pragma("unroll") for (int m = 0; m < 4; ++m)
#define EPI_FENCE(m) do { if ((m) & 1) asm volatile("" ::: "memory"); } while (0)

struct EpiInA {
    static constexpr bool PERM = true, AFTER_DRAIN = false;
    bf16_t* out; const float* rowss; const float* qn; const float* kn; const float* rope; PG8_LAS float* P; float qscale;
    __device__ __forceinline__ void operator()(const f32x4 (&acc)[2][2][4][2], const Unit& u, int wr, int wc, int fr, int fq) const {
        int rl0 = wr * 64 + fr; asm volatile("" : "+v"(rl0)); const int col0 = u.pn * 256 + wc * 32 + 8 * fq;
        stage_rowscale(P + 2048, rowss, u.pm);
        if (u.pn < 8) {
            EPI_ROWS(ai, m) { const int rl = ai * 128 + rl0 + m * 16; const float rs = P[2048 + rl];
#pragma unroll
                for (int bj = 0; bj < 2; ++bj) { const f32x4 a = acc[ai][bj][m][0] * rs, b = acc[ai][bj][m][1] * rs;
                    float ss = (a[0] * a[0] + a[1] * a[1]) + (a[2] * a[2] + a[3] * a[3]) + (b[0] * b[0] + b[1] * b[1]) + (b[2] * b[2] + b[3] * b[3]);
                    ss += __shfl_xor(ss, 16); ss += __shfl_xor(ss, 32);
                    if (fq == 0) P[rl * 8 + bj * 4 + wc] = ss; }
                EPI_FENCE(m); }
            asm volatile("s_waitcnt lgkmcnt(0)" ::: "memory"); __builtin_amdgcn_s_barrier(); asm volatile("" ::: "memory");
            const float* gp = (u.pn < 6) ? qn : kn; const float sc = (u.pn < 6) ? qscale : 1.f;
            const f32x4 g0 = *(const f32x4*)(gp + 16 * wc + 4 * fq) * sc, g1 = *(const f32x4*)(gp + 64 + 16 * wc + 4 * fq) * sc;
            EPI_ROWS(ai, m) { const int rl = ai * 128 + rl0 + m * 16; const int row = u.pm * 256 + rl; const float rs = P[2048 + rl];
                const u32x4 cw = *(const u32x4*)((const unsigned*)rope + (size_t)row * 64 + 16 * wc + 4 * fq);
#define H2F_LO(w_) ((float)__builtin_bit_cast(_Float16, (unsigned short)((w_) & 0xffffu)))
#define H2F_HI(w_) ((float)__builtin_bit_cast(_Float16, (unsigned short)((w_) >> 16)))
                const f32x4 cs = {H2F_LO(cw[0]), H2F_LO(cw[1]), H2F_LO(cw[2]), H2F_LO(cw[3])}, sn = {H2F_HI(cw[0]), H2F_HI(cw[1]), H2F_HI(cw[2]), H2F_HI(cw[3])};
#pragma unroll
                for (int bj = 0; bj < 2; ++bj) { const f32x4 pp = *(const PG8_LAS f32x4*)(P + rl * 8 + bj * 4);
                    const float hn = rsqrtf(((pp[0] + pp[1]) + (pp[2] + pp[3])) * (1.f / 128.f) + EPS_) * rs;
                    const f32x4 x1 = acc[ai][bj][m][0] * hn * g0, x2 = acc[ai][bj][m][1] * hn * g1;
                    const f32x4 o1 = x1 * cs - x2 * sn, o2 = x2 * cs + x1 * sn;
                    *(u32x4*)(out + (size_t)row * 2560 + col0 + bj * 128) = pk8(o1, o2); } asm volatile("" ::: "memory"); }
        } else {
            EPI_ROWS(ai, m) { const int rl = ai * 128 + rl0 + m * 16; const int row = u.pm * 256 + rl; const float rs = P[2048 + rl];
#pragma unroll
                for (int bj = 0; bj < 2; ++bj) *(u32x4*)(out + (size_t)row * 2560 + col0 + bj * 128) = pk8(acc[ai][bj][m][0] * rs, acc[ai][bj][m][1] * rs); EPI_FENCE(m); }
        }
    }
};
struct EpiInB {
    static constexpr bool PERM = true, AFTER_DRAIN = false;
    bf16_t* out; bf16_t* rb; float* ab; const float* rowss; PG8_LAS float* RS;
    __device__ __forceinline__ void operator()(const f32x4 (&acc)[2][2][4][2], const Unit& u, int wr, int wc, int fr, int fq) const {
        int rl0 = wr * 64 + fr; asm volatile("" : "+v"(rl0)); const int cin = wc * 32 + 8 * fq;
        stage_rowscale(RS, rowss, u.pm);
        EPI_ROWS(ai, m) { const int rl = ai * 128 + rl0 + m * 16; const int row = u.pm * 256 + rl; float rs = RS[rl];
            if (u.pn < 8) { if (u.pn < 2) rs *= 0.08838834764831845f;
#pragma unroll
                for (int bj = 0; bj < 2; ++bj) *(u32x4*)(out + (size_t)row * 2048 + u.pn * 256 + cin + bj * 128) = pk8(acc[ai][bj][m][0] * rs, acc[ai][bj][m][1] * rs);
            } else if (u.pn < 12) {
#pragma unroll
                for (int bj = 0; bj < 2; ++bj) *(u32x4*)(rb + (size_t)row * 1024 + (u.pn - 8) * 256 + cin + bj * 128) = pk8(silu4(acc[ai][bj][m][0] * rs), silu4(acc[ai][bj][m][1] * rs));
            } else if (wc == 0 && fq < 2) {
                *(f32x4*)(ab + (size_t)row * 16 + 8 * fq) = acc[ai][0][m][0] * rs; *(f32x4*)(ab + (size_t)row * 16 + 8 * fq + 4) = acc[ai][0][m][1] * rs;
            } EPI_FENCE(m); }
    }
};
__device__ __forceinline__ unsigned pkq4(f32x4 v) { unsigned r = 0u; r = __builtin_amdgcn_cvt_pk_u8_f32(v[0] * 255.f, 0, r); r = __builtin_amdgcn_cvt_pk_u8_f32(v[1] * 255.f, 1, r); r = __builtin_amdgcn_cvt_pk_u8_f32(v[2] * 255.f, 2, r); r = __builtin_amdgcn_cvt_pk_u8_f32(v[3] * 255.f, 3, r); return r; }
__device__ __forceinline__ f32x4 unq4(unsigned w) { return (f32x4){(float)(w & 0xffu), (float)((w >> 8) & 0xffu), (float)((w >> 16) & 0xffu), (float)(w >> 24)} * (1.f / 255.f); }
struct EpiInC {
    static constexpr bool PERM = true, AFTER_DRAIN = false;
    unsigned char* ga; unsigned char* gb; const float* rowss; PG8_LAS float* RS;
    __device__ __forceinline__ void operator()(const f32x4 (&acc)[2][2][4][2], const Unit& u, int wr, int wc, int fr, int fq) const {
        int rl0 = wr * 64 + fr; asm volatile("" : "+v"(rl0)); unsigned char* base = (u.pn < 4) ? ga : gb; const int col0 = (u.pn & 3) * 256 + wc * 32 + 8 * fq;
        stage_rowscale(RS, rowss, u.pm);
        EPI_ROWS(ai, m) { const int rl = ai * 128 + rl0 + m * 16; const int row = u.pm * 256 + rl; const float rs = RS[rl];
#pragma unroll
            for (int bj = 0; bj < 2; ++bj) { u32x2 q; q.x = pkq4(sigm4(acc[ai][bj][m][0] * rs)); q.y = pkq4(sigm4(acc[ai][bj][m][1] * rs)); *(u32x2*)(base + (size_t)row * 1024 + col0 + bj * 128) = q; } EPI_FENCE(m); }
    }
};
template <int MODE> struct EpiProj {
    static constexpr bool PERM = true, AFTER_DRAIN = false;
    bf16_t* y; const unsigned char* gq;
    __device__ __forceinline__ void operator()(const f32x4 (&acc)[2][2][4][2], const Unit& u, int wr, int wc, int fr, int fq) const {
        int rl0 = wr * 64 + fr; asm volatile("" : "+v"(rl0)); const int col0 = u.pn * 256 + wc * 32 + 8 * fq;
        EPI_ROWS(ai, m) { const int row = u.pm * 256 + ai * 128 + rl0 + m * 16;
#pragma unroll
            for (int bj = 0; bj < 2; ++bj) { const size_t off = (size_t)row * 1024 + col0 + bj * 128; const u32x2 q = *(const u32x2*)(gq + off);
                f32x4 a = unq4(q.x) * acc[ai][bj][m][0], b = unq4(q.y) * acc[ai][bj][m][1];
                if (MODE == 1) { f32x4 c, d; unpk8(*(const u32x4*)(y + off), c, d); a = a + c; b = b + d; }
                *(u32x4*)(y + off) = pk8(a, b); } EPI_FENCE(m); }
    }
};
template <int MODE> struct EpiRes {
    static constexpr bool PERM = true, AFTER_DRAIN = false;
    const float* xin; float* xout; bf16_t* xb; bf16_t* lo; float* ssout; int last;
    __device__ __forceinline__ void operator()(const f32x4 (&acc)[2][2][4][2], const Unit& u, int wr, int wc, int fr, int fq) const {
        int rl0 = wr * 64 + fr; asm volatile("" : "+v"(rl0)); const int col0 = u.pn * 256 + wc * 32 + 8 * fq;
        EPI_ROWS(ai, m) { const int row = u.pm * 256 + ai * 128 + rl0 + m * 16; float ss = 0.f;
#pragma unroll
            for (int bj = 0; bj < 2; ++bj) { const size_t off = (size_t)row * 1024 + col0 + bj * 128; f32x4 a, b;
                if (MODE == 0) { a = *(const f32x4*)(xin + off) + acc[ai][bj][m][0]; b = *(const f32x4*)(xin + off + 4) + acc[ai][bj][m][1];
                    const u32x4 hi = pk8(a, b); f32x4 ha, hb2; unpk8(hi, ha, hb2);
                    *(u32x4*)(xb + off) = hi; *(u32x4*)(lo + off) = pk8(a - ha, b - hb2); }
                else { f32x4 ha, hb2, la, lb; unpk8(*(const u32x4*)(xb + off), ha, hb2); unpk8(*(const u32x4*)(lo + off), la, lb);
                    a = (ha + la) + acc[ai][bj][m][0]; b = (hb2 + lb) + acc[ai][bj][m][1];
                    *(f32x4*)(xout + off) = a; *(f32x4*)(xout + off + 4) = b; if (!last) *(u32x4*)(xb + off) = pk8(a, b); }
                ss += (a[0] * a[0] + a[1] * a[1]) + (a[2] * a[2] + a[3] * a[3]) + (b[0] * b[0] + b[1] * b[1]) + (b[2] * b[2] + b[3] * b[3]); }
            ss += __shfl_xor(ss, 16); ss += __shfl_xor(ss, 32);
            if (fq == 0 && !last) ssout[(size_t)row * 16 + u.pn * 4 + wc] = ss; EPI_FENCE(m); }
    }
};
struct EpiFFN {
    static constexpr bool PERM = true, AFTER_DRAIN = false;
    bf16_t* hb; const float* rowss; PG8_LAS float* RS;
    __device__ __forceinline__ void operator()(const f32x4 (&acc)[2][2][4][2], const Unit& u, int wr, int wc, int fr, int fq) const {
        int rl0 = wr * 64 + fr; asm volatile("" : "+v"(rl0)); const int col0 = u.pn * 128 + wc * 32 + 8 * fq;
        stage_rowscale(RS, rowss, u.pm);
        EPI_ROWS(ai, m) { const int rl = ai * 128 + rl0 + m * 16; const int row = u.pm * 256 + rl; const float rs = RS[rl];
            const f32x4 a = silu4(acc[ai][0][m][0] * rs) * (acc[ai][1][m][0] * rs), b = silu4(acc[ai][0][m][1] * rs) * (acc[ai][1][m][1] * rs);
            *(u32x4*)(hb + (size_t)row * 2816 + col0) = pk8(a, b); EPI_FENCE(m); }
    }
};
template <class Epi, class Sched, bool ALIGN_EPI = false, bool SP2 = false>
__device__ __forceinline__ void gemm_phase(PG8_LAS unsigned char* lds, const Gemm g, const Sched& S, const Epi& E) {
    int tid_raw = threadIdx.x; asm volatile("" : "+v"(tid_raw));
    const int tid = tid_raw, wid = __builtin_amdgcn_readfirstlane(tid >> 6), lane = tid & 63, wr = wid >> 2, wc = wid & 3, fr = lane & 15, fq = lane >> 4;
    const int K = g.K, nt = K / BK;
    unsigned voffA[2], voffB[2];
#pragma unroll
    for (int i = 0; i < 2; ++i) { int R, C; stage_rc(tid * 16 + i * 8192, R, C); const int Rb = Epi::PERM ? ((R & ~31) + perm32(R & 31)) : R;
        voffA[i] = (unsigned)(R * K + C) * 2u; voffB[i] = (unsigned)(Rb * K + C) * 2u; }
    const size_t kstep = (size_t)(BK * 2);
    const size_t hstep = (size_t)HALF * K * 2;
    const size_t tstep = 2 * hstep;
    const unsigned ldsw = (unsigned)wid * 1024u;
    const int aoff = lds_byte(wr * 64 + fr, fq * 8), boff = lds_byte(wc * 32 + fr, fq * 8);
#define PG8_SA(b, h) (((b) * 2 + (h)) * HTB)
#define PG8_SB(b, h) ((4 + (b) * 2 + (h)) * HTB)
#define PG8_STAGE(bufoff, gbase, voff) do { _Pragma("unroll") for (int _i = 0; _i < 2; ++_i) \
        __builtin_amdgcn_global_load_lds((const unsigned*)((const char*)(gbase) + (voff)[_i]), (PG8_LAS unsigned*)(lds + (bufoff) + ldsw + _i * 8192), 16, 0, 0); } while (0)
#define PG8_LDA(dst, b, h) do { _Pragma("unroll") for (int m = 0; m < 4; ++m) _Pragma("unroll") for (int k = 0; k < 2; ++k) dst[m][k] = *(const PG8_LAS bf16x8*)(lds + PG8_SA(b, h) + aoff + m * 2048 + k * 1024); } while (0)
#define PG8_LDB(dst, b, h) do { _Pragma("unroll") for (int n = 0; n < 2; ++n) _Pragma("unroll") for (int k = 0; k < 2; ++k) dst[n][k] = *(const PG8_LAS bf16x8*)(lds + PG8_SB(b, h) + boff + n * 2048 + k * 1024); } while (0)
#define PG8_MMA(ai, bj, At, Bt) do { __builtin_amdgcn_s_setprio(1); _Pragma("unroll") for (int m = 0; m < 4; ++m) _Pragma("unroll") for (int n = 0; n < 2; ++n) _Pragma("unroll") for (int k = 0; k < 2; ++k) \
        acc[ai][bj][m][n] = __builtin_amdgcn_mfma_f32_16x16x32_bf16(Bt[n][k], At[m][k], acc[ai][bj][m][n], 0, 0, 0); __builtin_amdgcn_s_setprio(0); } while (0)
#define PG8_WAIT_V(n) asm volatile("s_waitcnt vmcnt(" #n ")" ::: "memory")
#define PG8_WAIT_L(n) asm volatile("s_waitcnt lgkmcnt(" #n ")" ::: "memory")
#define PG8_BAR __builtin_amdgcn_s_barrier()
#define PG8_SCHED __builtin_amdgcn_sched_barrier(0)
    Unit cur, nxt; int ui = 0;
    if (!S.next(0, cur)) return;
    f32x4 acc[2][2][4][2];
#pragma unroll
    for (int a = 0; a < 2; ++a)
#pragma unroll
        for (int b = 0; b < 2; ++b)
#pragma unroll
            for (int m = 0; m < 4; ++m)
#pragma unroll
                for (int n = 0; n < 2; ++n) acc[a][b][m][n] = (f32x4){0.f, 0.f, 0.f, 0.f};
    bf16x8 At[4][2], B0[2][2], B1[2][2];
    const char* cA = (const char*)g.A + (size_t)cur.pm * tstep; const char* cB = (const char*)g.Bt + (size_t)cur.pn * tstep;
    S.a_ready(cur);
    if constexpr (SP2) {
        PG8_STAGE(PG8_SB(0, 0), cB, voffB); PG8_STAGE(PG8_SB(0, 1), cB + hstep, voffB); PG8_STAGE(PG8_SA(0, 0), cA, voffA); PG8_STAGE(PG8_SA(0, 1), cA + hstep, voffA);
        if (wr == 1) PG8_BAR;
        PG8_WAIT_V(2); PG8_BAR;
        PG8_STAGE(PG8_SB(1, 0), cB + kstep, voffB); PG8_STAGE(PG8_SA(1, 0), cA + kstep, voffA); PG8_STAGE(PG8_SB(1, 1), cB + hstep + kstep, voffB);
        PG8_WAIT_V(6); PG8_BAR;
    } else {
        PG8_STAGE(PG8_SB(0, 0), cB, voffB); PG8_STAGE(PG8_SA(0, 0), cA, voffA); PG8_STAGE(PG8_SB(0, 1), cB + hstep, voffB); PG8_STAGE(PG8_SA(0, 1), cA + hstep, voffA);
        if (wr == 1) PG8_BAR;
        PG8_WAIT_V(4); PG8_BAR;
        PG8_STAGE(PG8_SB(1, 0), cB + kstep, voffB); PG8_STAGE(PG8_SA(1, 0), cA + kstep, voffA); PG8_STAGE(PG8_SB(1, 1), cB + hstep + kstep, voffB);
        PG8_WAIT_V(6); PG8_BAR;
    }
    for (;;) {
        const bool has_next = S.next(ui + 1, nxt);
        const char* nA = has_next ? (const char*)g.A + (size_t)nxt.pm * tstep : cA; const char* nB = has_next ? (const char*)g.Bt + (size_t)nxt.pn * tstep : cB;
        for (int t = 0; t < nt; t += 2) {
            const bool last = (t == nt - 2);
            const char* a1 = cA + (size_t)(t + 1) * kstep;
            const char* a2 = last ? nA : cA + (size_t)(t + 2) * kstep; const char* b2 = last ? nB : cB + (size_t)(t + 2) * kstep;
            const char* a3 = a2 + kstep; const char* b3 = b2 + kstep;
            if (last && has_next) S.a_ready(nxt);
            if constexpr (SP2) {
            PG8_LDB(B0, 0, 0); PG8_LDB(B1, 0, 1); PG8_SCHED; PG8_LDA(At, 0, 0); PG8_STAGE(PG8_SA(1, 1), a1 + hstep, voffA);
            PG8_WAIT_V(8); PG8_WAIT_L(0); PG8_BAR; PG8_MMA(0, 0, At, B0); PG8_MMA(0, 1, At, B1); PG8_BAR; PG8_SCHED;
            PG8_LDA(At, 0, 1); PG8_STAGE(PG8_SB(0, 0), b2, voffB); PG8_STAGE(PG8_SB(0, 1), b2 + hstep, voffB); PG8_STAGE(PG8_SA(0, 0), a2, voffA);
            PG8_WAIT_V(8); PG8_WAIT_L(0); PG8_BAR; PG8_MMA(1, 0, At, B0); PG8_MMA(1, 1, At, B1); PG8_BAR; PG8_SCHED;
            PG8_LDB(B0, 1, 0); PG8_LDB(B1, 1, 1); PG8_SCHED; PG8_LDA(At, 1, 0); PG8_STAGE(PG8_SA(0, 1), a2 + hstep, voffA);
            PG8_WAIT_V(8); PG8_WAIT_L(0); PG8_BAR; PG8_MMA(0, 0, At, B0); PG8_MMA(0, 1, At, B1); PG8_BAR; PG8_SCHED;
            PG8_LDA(At, 1, 1); PG8_STAGE(PG8_SB(1, 0), b3, voffB); PG8_STAGE(PG8_SB(1, 1), b3 + hstep, voffB); PG8_STAGE(PG8_SA(1, 0), a3, voffA);
            PG8_WAIT_V(8); PG8_WAIT_L(0); PG8_BAR; PG8_MMA(1, 0, At, B0); PG8_MMA(1, 1, At, B1); PG8_BAR; PG8_SCHED;
            } else {
            PG8_LDB(B0, 0, 0); PG8_SCHED; PG8_LDA(At, 0, 0); PG8_STAGE(PG8_SA(1, 1), a1 + hstep, voffA);
            PG8_WAIT_L(8); PG8_BAR; PG8_WAIT_L(0); PG8_MMA(0, 0, At, B0); PG8_BAR; PG8_SCHED;
            PG8_LDB(B1, 0, 1); PG8_STAGE(PG8_SB(0, 0), b2, voffB);
            PG8_BAR; PG8_WAIT_L(0); PG8_MMA(0, 1, At, B1); PG8_BAR;
            PG8_LDA(At, 0, 1); PG8_STAGE(PG8_SA(0, 0), a2, voffA);
            PG8_BAR; PG8_WAIT_L(0); PG8_MMA(1, 0, At, B0); PG8_BAR; PG8_SCHED;
            PG8_STAGE(PG8_SB(0, 1), b2 + hstep, voffB);
            PG8_WAIT_V(6); PG8_BAR; PG8_MMA(1, 1, At, B1); PG8_BAR;
            PG8_LDB(B0, 1, 0); PG8_SCHED; PG8_LDA(At, 1, 0); PG8_STAGE(PG8_SA(0, 1), a2 + hstep, voffA);
            PG8_WAIT_L(8); PG8_BAR; PG8_WAIT_L(0); PG8_MMA(0, 0, At, B0); PG8_BAR; PG8_SCHED;
            PG8_LDB(B1, 1, 1); PG8_STAGE(PG8_SB(1, 0), b3, voffB);
            PG8_BAR; PG8_WAIT_L(0); PG8_MMA(0, 1, At, B1); PG8_BAR;
            PG8_LDA(At, 1, 1); PG8_STAGE(PG8_SA(1, 0), a3, voffA);
            PG8_BAR; PG8_WAIT_L(0); PG8_MMA(1, 0, At, B0); PG8_BAR; PG8_SCHED;
            PG8_STAGE(PG8_SB(1, 1), b3 + hstep, voffB);
            PG8_WAIT_V(6); PG8_BAR; PG8_MMA(1, 1, At, B1); PG8_BAR;
            }
        }
        if constexpr (ALIGN_EPI) { if (wr == 0) PG8_BAR; }
        if constexpr (!Epi::AFTER_DRAIN) { E(acc, cur, wr, wc, fr, fq); S.done(cur); }
        if (!has_next) break;
#pragma unroll
        for (int a = 0; a < 2; ++a)
#pragma unroll
            for (int b = 0; b < 2; ++b)
#pragma unroll
                for (int m = 0; m < 4; ++m)
#pragma unroll
                    for (int n = 0; n < 2; ++n) acc[a][b][m][n] = (f32x4){0.f, 0.f, 0.f, 0.f};
        cur = nxt; cA = nA; cB = nB; ++ui;
        if constexpr (ALIGN_EPI) { if (wr == 1) PG8_BAR; }
    }
    PG8_WAIT_V(0);
    if constexpr (!ALIGN_EPI) { if (wr == 0) PG8_BAR; }
    PG8_BAR;
    if constexpr (Epi::AFTER_DRAIN) { E.fused(acc, cur, wr, wc, fr, fq, lds, wid, lane); S.done(cur); }
#undef PG8_SA
#undef PG8_SB
#undef PG8_STAGE
#undef PG8_LDA
#undef PG8_LDB
#undef PG8_MMA
#undef PG8_WAIT_V
#undef PG8_WAIT_L
#undef PG8_BAR
#undef PG8_SCHED
}
}
using namespace pg8;
#define LAS __attribute__((address_space(3)))
#define DI __device__ __forceinline__
typedef short s16x4 __attribute__((ext_vector_type(4)));
typedef short v4i16_t __attribute__((ext_vector_type(4)));
typedef float f32x16 __attribute__((ext_vector_type(16)));
constexpr int T = 32768, SEQ = 2048, DEPTH = 4;
constexpr float EPS = 1e-6f;
constexpr float QSCALE = 0.08838834764831845f * 1.4426950408889634f;
constexpr size_t MiB = 1u << 20, HM = 1u << 19;
constexpr size_t W_LAYER = 37 * MiB;
constexpr size_t W_INA = 0, W_INB = 5 * MiB, W_INC = 11 * MiB + HM, W_PA = 15 * MiB + HM, W_PB = 16 * MiB + HM, W_OUT = 18 * MiB + HM, W_GU = 20 * MiB + HM, W_D = 31 * MiB + HM;
constexpr size_t WS_XB = 74 * MiB, WS_R = 138 * MiB;
constexpr size_t R_OG = 0, R_BUFA = 96 * MiB, R_BUFB = 96 * MiB, R_RB = 224 * MiB, R_GA = 32 * MiB, R_GB = 96 * MiB, R_HB = 96 * MiB;
constexpr size_t WS_ROPE = 426 * MiB, WS_AB = 434 * MiB, WS_DEN = 436 * MiB, WS_ROWSS = 438 * MiB, WS_BLG = 442 * MiB, WS_BAR = 443 * MiB, WS_GB = 444 * MiB, WS_END = 508 * MiB;
constexpr int LDS_BYTES = 147456, EPI_LDS = 131072;
struct Args { const float* in[16]; float* out; unsigned char* ws; };

#define MFMA32(a, b, c) __builtin_amdgcn_mfma_f32_32x32x16_bf16((a), (b), (c), 0, 0, 0)
DI int crow(int reg, int h) { return (reg & 3) + 8 * (reg >> 2) + 4 * h; }
DI bf16x8 pack8(const f32x16& x, int s) { u32x4 p; p.x = pk2(x[8 * s], x[8 * s + 1]); p.y = pk2(x[8 * s + 2], x[8 * s + 3]); p.z = pk2(x[8 * s + 4], x[8 * s + 5]); p.w = pk2(x[8 * s + 6], x[8 * s + 7]); return __builtin_bit_cast(bf16x8, p); }
DI s16x4 vtr(const LAS unsigned char* p) { return __builtin_bit_cast(s16x4, __builtin_amdgcn_ds_read_tr16_b64_v4i16((LAS v4i16_t*)p)); }
DI bf16x8 cat8(s16x4 lo, s16x4 hi) { return __builtin_shufflevector(lo, hi, 0, 1, 2, 3, 4, 5, 6, 7); }
DI f32x16 zero16() { float z = 0.f; asm volatile("" : "+v"(z)); f32x16 r;
#pragma unroll
    for (int i = 0; i < 16; ++i) r[i] = z;
    return r; }
DI float wave_sum(float v) {
#pragma unroll
    for (int o = 1; o < 64; o <<= 1) v += __shfl_xor(v, o);
    return v;
}

DI void conv_tile(const float* src, int ldw, int K, int col, const float* ksc, bf16_t* WT, int p0, int k0, LAS float* scr, int lane) {
#pragma unroll 16
    for (int i = 0; i < 32; ++i) { const int kk = 2 * i + (lane >> 5); float v = 0.f;
        if (col >= 0) { v = src[(size_t)(k0 + kk) * ldw + col]; if (ksc) v *= ksc[k0 + kk]; }
        scr[kk * 33 + (lane & 31)] = v; }
    asm volatile("s_waitcnt lgkmcnt(0)" ::: "memory");
    const int c = lane & 7;
#pragma unroll
    for (int j = 0; j < 4; ++j) { const int n = (lane >> 3) + 8 * j; const LAS float* s = scr + (8 * c) * 33 + n;
        u32x4 o; o.x = pk2(s[0 * 33], s[1 * 33]); o.y = pk2(s[2 * 33], s[3 * 33]); o.z = pk2(s[4 * 33], s[5 * 33]); o.w = pk2(s[6 * 33], s[7 * 33]);
        *(u32x4*)(WT + (size_t)(p0 + n) * K + k0 + 8 * c) = o; }
    asm volatile("s_waitcnt lgkmcnt(0)" ::: "memory");
}
constexpr int CONV_ITEMS = 1280 + 1664 + 1024 + 256 + 512 + 512 + 2816 + 1408;
DI void conv_layer(const Args& a, int l, unsigned char* wbytes, LAS float* scr, int gw, int ngw) {
    int lane = threadIdx.x; asm volatile("" : "+v"(lane)); lane &= 63;
    const float* win = a.in[3] + (size_t)l * 1024 * 7696; const float* n1 = a.in[2] + l * 1024; const float* n2 = a.in[12] + l * 1024;
    const int pl = lane & 31;
    for (int it = gw; it < CONV_ITEMS; it += ngw) {
        int r = it;
        if (r < 1280) { const int nb = r % 80, kb = r / 80, p = 32 * nb + pl; int col = p;
            if (p < 2048) { const int w = p & 127, j = w >> 3, e = w & 7; col = (p & ~127) + (e < 4 ? 4 * j + e : 64 + 4 * j + e - 4); }
            conv_tile(win, 7696, 1024, col, n1, (bf16_t*)(wbytes + W_INA), 32 * nb, 64 * kb, scr, lane); continue; }
        r -= 1280;
        if (r < 1664) { const int nb = r % 104, kb = r / 104, p = 32 * nb + pl; const int col = p < 3072 ? 2560 + p : (p < 3088 ? 5632 + (p - 3072) : -1);
            conv_tile(win, 7696, 1024, col, n1, (bf16_t*)(wbytes + W_INB), 32 * nb, 64 * kb, scr, lane); continue; }
        r -= 1664;
        if (r < 1024) { const int nb = r % 64, kb = r / 64, p = 32 * nb + pl;
            conv_tile(win, 7696, 1024, 5648 + p, n1, (bf16_t*)(wbytes + W_INC), 32 * nb, 64 * kb, scr, lane); continue; }
        r -= 1024;
        if (r < 256) { const int nb = r % 32, kb = r / 32;
            conv_tile(a.in[9] + (size_t)l * 512 * 1024, 1024, 512, 32 * nb + pl, nullptr, (bf16_t*)(wbytes + W_PA), 32 * nb, 64 * kb, scr, lane); continue; }
        r -= 256;
        if (r < 512) { const int nb = r % 32, kb = r / 32;
            conv_tile(a.in[10] + (size_t)l * 1024 * 1024, 1024, 1024, 32 * nb + pl, nullptr, (bf16_t*)(wbytes + W_PB), 32 * nb, 64 * kb, scr, lane); continue; }
        r -= 512;
        if (r < 512) { const int nb = r % 32, kb = r / 32;
            conv_tile(a.in[11] + (size_t)l * 1024 * 1024, 1024, 1024, 32 * nb + pl, nullptr, (bf16_t*)(wbytes + W_OUT), 32 * nb, 64 * kb, scr, lane); continue; }
        r -= 512;
        if (r < 2816) { const int nb = r % 176, kb = r / 176, p = 32 * nb + pl, t = p >> 8, c = p & 255;
            const float* src = (c < 128 ? a.in[13] : a.in[14]) + (size_t)l * 1024 * 2816;
            conv_tile(src, 2816, 1024, 128 * t + (c & 127), n2, (bf16_t*)(wbytes + W_GU), 32 * nb, 64 * kb, scr, lane); continue; }
        r -= 2816;
        { const int nb = r % 32, kb = r / 32;
            conv_tile(a.in[15] + (size_t)l * 2816 * 1024, 1024, 2816, 32 * nb + pl, nullptr, (bf16_t*)(wbytes + W_D), 32 * nb, 64 * kb, scr, lane); }
    }
}

struct AttnU { int b, h, g, d, r, nb, jstart; };
DI AttnU attn_decode(int idx) { AttnU u; const int rem = idx % 192, uu = rem & 15; u.b = idx / 192; u.h = rem / 48; u.g = (rem % 48) >> 4; const int sh = 2 * u.g; u.d = 1 << sh; u.r = uu & (u.d - 1); u.nb = uu >> sh; u.jstart = (u.nb == 0) ? 128 : 0; return u; }
DI void attn_phase(LAS unsigned char* lds, const bf16_t* bufA, bf16_t* OG, float* DEN, int bid, int G) {
    int tid_raw = threadIdx.x; asm volatile("" : "+v"(tid_raw));
    const int tid = tid_raw, lane = tid & 63, w = __builtin_amdgcn_readfirstlane(tid >> 6), l31 = lane & 31, h2 = lane >> 5;
    const int qt = w >> 1, dbase = 2 * (w & 1), q4 = (lane & 15) >> 2, p4 = lane & 3, blk = (lane >> 4) & 1;
    LAS unsigned char* Ks = lds; LAS unsigned char* Vs = lds + 65536;
    const int per = (3072 + G - 1) / G, u0 = bid * per, u1 = (u0 + per < 3072) ? u0 + per : 3072;
    u32x4 kreg[8], vreg[8];
#define ATTN_ISSUE(U) do { _Pragma("unroll") for (int it = 0; it < 8; ++it) { const int e = tid + 512 * it, j = e >> 4, ch = e & 15; \
        if (j >= (U).jstart) { const int tk = (((U).nb - 1) * 128 + j) * (U).d + (U).r; const bf16_t* src = bufA + ((size_t)(U).b * SEQ + tk) * 2560 + (U).h * 128 + ch * 8; \
            kreg[it] = *(const u32x4*)(src + 1536); vreg[it] = *(const u32x4*)(src + 2048); } } } while (0)
    if (u0 < u1) { const AttnU un = attn_decode(u0); ATTN_ISSUE(un); }
    for (int idx = u0; idx < u1; ++idx) {
        const AttnU cu = attn_decode(idx);
        const int b = cu.b, h = cu.h, g = cu.g, d = cu.d, r = cu.r, nb = cu.nb, jstart = cu.jstart;
        const size_t rowb = (size_t)b * SEQ;
        const int iq = 32 * qt + l31, tq = (nb * 128 + iq) * d + r;
        const bf16_t* qp = bufA + (rowb + tq) * 2560 + (g * 4 + h) * 128 + 8 * h2;
        bf16x8 qf[8];
#pragma unroll
        for (int ks = 0; ks < 8; ++ks) qf[ks] = *(const bf16x8*)(qp + 16 * ks);
        __syncthreads();
#pragma unroll
        for (int it = 0; it < 8; ++it) { const int e = tid + 512 * it, j = e >> 4, ch = e & 15;
            if (j >= jstart) { const int o = 256 * j + 16 * (ch ^ (j & 15)); *(LAS u32x4*)(Ks + o) = kreg[it]; *(LAS u32x4*)(Vs + o) = vreg[it]; } }
        __syncthreads();
        if (idx + 1 < u1) { const AttnU un = attn_decode(idx + 1); ATTN_ISSUE(un); }
        f32x16 o0 = {}, o1 = {}; float den = 0.f;
        const int kb0 = (jstart >> 5) > qt ? (jstart >> 5) : qt;
        for (int kb = kb0; kb <= qt + 4; ++kb) {
            f32x16 s = zero16();
            const int key = 32 * kb + l31, sw = key & 15; const LAS unsigned char* kr = Ks + 256 * key;
#pragma unroll
            for (int ks = 0; ks < 8; ++ks) { const bf16x8 av = *(const LAS bf16x8*)(kr + 16 * ((2 * ks + h2) ^ sw)); s = MFMA32(av, qf[ks], s); }
            bf16x8 vfr[2][2];
#pragma unroll
            for (int s2 = 0; s2 < 2; ++s2) { const int key0 = 32 * kb + 16 * s2 + 4 * h2 + q4, key1 = key0 + 8;
#pragma unroll
                for (int dbi = 0; dbi < 2; ++dbi) { const int chunk = 4 * (dbase + dbi) + 2 * blk + (p4 >> 1);
                    const s16x4 lo = vtr(Vs + 256 * key0 + 16 * (chunk ^ (key0 & 15)) + 8 * (p4 & 1));
                    const s16x4 hi = vtr(Vs + 256 * key1 + 16 * (chunk ^ (key1 & 15)) + 8 * (p4 & 1)); vfr[s2][dbi] = cat8(lo, hi); } }
            const bool interior = (kb > qt) && (kb < qt + 4);
            if (interior) {
#pragma unroll
                for (int reg = 0; reg < 16; ++reg) { const float p = __builtin_amdgcn_exp2f(s[reg]); s[reg] = p; den += p; }
            } else {
#pragma unroll
                for (int reg = 0; reg < 16; ++reg) { const int j = 32 * kb + crow(reg, h2); const bool ok = (j >= iq) && (j <= iq + 128);
                    const float p = ok ? __builtin_amdgcn_exp2f(s[reg]) : 0.f; s[reg] = p; den += p; }
            }
#pragma unroll
            for (int s2 = 0; s2 < 2; ++s2) { const bf16x8 pb = pack8(s, s2);
                o0 = MFMA32(vfr[s2][0], pb, o0); o1 = MFMA32(vfr[s2][1], pb, o1); }
        }
        den += __shfl_xor(den, 32);
        bf16_t* op = OG + (size_t)g * T * 512 + (rowb + tq) * 512 + h * 128 + 4 * h2;
#pragma unroll
        for (int rg = 0; rg < 4; ++rg) {
            u32x2 v0; v0.x = pk2(o0[4 * rg], o0[4 * rg + 1]); v0.y = pk2(o0[4 * rg + 2], o0[4 * rg + 3]); *(u32x2*)(op + 32 * dbase + 8 * rg) = v0;
            u32x2 v1; v1.x = pk2(o1[4 * rg], o1[4 * rg + 1]); v1.y = pk2(o1[4 * rg + 2], o1[4 * rg + 3]); *(u32x2*)(op + 32 * (dbase + 1) + 8 * rg) = v1; }
        if ((w & 1) == 0 && h2 == 0) DEN[(rowb + tq) * 12 + h * 3 + g] = den;
    }
#undef ATTN_ISSUE
}
DI void ab_task(const bf16_t* xb, const bf16_t* wabT, const float* rowss, float* ABUF, int bid, int G) {
    int t = threadIdx.x; asm volatile("" : "+v"(t));
    const int lane = t & 63, w = __builtin_amdgcn_readfirstlane(t >> 6), li = lane & 15, lg = lane >> 4;
    for (int blk = bid * 8 + w; blk < T / 16; blk += G * 8) {
        const int row0 = blk * 16;
        const bf16_t* ap = xb + (size_t)(row0 + li) * 1024 + 8 * lg; const bf16_t* bp = wabT + (size_t)li * 1024 + 8 * lg;
        f32x4 acc = {0.f, 0.f, 0.f, 0.f};
#pragma unroll 16
        for (int c = 0; c < 32; ++c) acc = __builtin_amdgcn_mfma_f32_16x16x32_bf16(*(const bf16x8*)(ap + 32 * c), *(const bf16x8*)(bp + 32 * c), acc, 0, 0, 0);
#pragma unroll
        for (int e = 0; e < 4; ++e) { const int row = row0 + 4 * lg + e; ABUF[(size_t)row * 16 + li] = acc[e] * rowscale(rowss, row); }
    }
}
DI void combine_pass(bf16_t* OG, const float* DEN, int hid, int HN) {
    const size_t n8 = (size_t)T * 64, G1 = (size_t)T * 512;
    int tid_raw = threadIdx.x; asm volatile("" : "+v"(tid_raw));
    for (size_t i = (size_t)hid * 512 + tid_raw; i < n8; i += (size_t)HN * 512) { const size_t t = i >> 6; const int h = (int)(i & 63) >> 4;
        const float* dp = DEN + t * 12 + h * 3; const float inv = 1.f / (dp[0] + dp[1] + dp[2]);
        f32x4 a0, b0, a1, b1, a2, b2; unpk8(*(const u32x4*)(OG + i * 8), a0, b0); unpk8(*(const u32x4*)(OG + G1 + i * 8), a1, b1); unpk8(*(const u32x4*)(OG + 2 * G1 + i * 8), a2, b2);
        *(u32x4*)(OG + i * 8) = pk8((a0 + a1 + a2) * inv, (b0 + b1 + b2) * inv); }
}


DI u32x4 ld16_agent(const void* p) { const unsigned long long* q = (const unsigned long long*)p;
    const unsigned long long a = __hip_atomic_load(q, __ATOMIC_RELAXED, __HIP_MEMORY_SCOPE_AGENT), b = __hip_atomic_load(q + 1, __ATOMIC_RELAXED, __HIP_MEMORY_SCOPE_AGENT);
    return (u32x4){(unsigned)a, (unsigned)(a >> 32), (unsigned)b, (unsigned)(b >> 32)}; }
DI unsigned ld2_agent(const bf16_t* p) { return (unsigned)__hip_atomic_load(p, __ATOMIC_RELAXED, __HIP_MEMORY_SCOPE_AGENT); }
constexpr int G_QT = 0, G_KT = 16384, G_VT = 32768, G_OST = 65536, G_ABS = 98304, G_SEG = 102400, G_BL = 104448, G_GN = 104960, G_WU = 105984;
constexpr int GLA_UNITS = 64 * 32;
DI void gla1_phase(LAS unsigned char* lds, bf16_t* bufB, const float* ABUF, const float* wup, const float* ba, float* BLG, int bid, int G) {
    int tid_raw = threadIdx.x; asm volatile("" : "+v"(tid_raw));
#define GLA_IDS() int tid = tid_raw; asm volatile("" : "+v"(tid)); const int lane = tid & 63, l31 = lane & 31, h2 = lane >> 5, q4 = (lane & 15) >> 2, p4 = lane & 3, blk = (lane >> 4) & 1, dch = tid & 127, seg = tid >> 7; (void)l31; (void)h2; (void)q4; (void)p4; (void)blk; (void)dch; (void)seg
    LAS unsigned char* QT = lds + G_QT; LAS unsigned char* KT = lds + G_KT; LAS unsigned char* OST = lds + G_OST;
    LAS float* ABS = (LAS float*)(lds + G_ABS); LAS float* SEG = (LAS float*)(lds + G_SEG); LAS float* WU = (LAS float*)(lds + G_WU);
    int hprev = -1;
    f32x2 p_ab = {0.f, 0.f}; u32x4 p_q[2], p_k[2];
#define GLA1_ISSUE(UN) do { int t_ = tid_raw; asm volatile("" : "+v"(t_)); const int st_ = (UN) >> 5, c_ = (UN) & 31, b_ = st_ >> 2, h_ = st_ & 3; const size_t tk_ = (size_t)b_ * SEQ + c_ * 64; \
        p_ab = *(const f32x2*)(ABUF + tk_ * 16 + 2 * t_); \
        _Pragma("unroll") for (int i = 0; i < 2; ++i) { const int e = t_ + 512 * i, row = e >> 4, ch = e & 15; const bf16_t* src = bufB + (tk_ + row) * 2048 + h_ * 128 + ch * 8; p_q[i] = *(const u32x4*)src; p_k[i] = *(const u32x4*)(src + 512); } } while (0)
    if (bid < GLA_UNITS) GLA1_ISSUE(bid);
#pragma nounroll
    for (int unit = bid; unit < GLA_UNITS; unit += G) {
        const int st = unit >> 5, c = unit & 31, b = st >> 2, h = st & 3;
        const size_t tok0 = (size_t)b * SEQ + c * 64;
        __syncthreads();
        if (h != hprev) { GLA_IDS(); hprev = h;
            if (tid < 128) {
#pragma unroll
                for (int r = 0; r < 16; ++r) WU[r * 128 + tid] = wup[r * 512 + h * 128 + tid];
                WU[16 * 128 + tid] = ba[h * 128 + tid]; } }
        { GLA_IDS();
        *(LAS f32x2*)(ABS + 2 * tid) = p_ab;
#pragma unroll
        for (int i = 0; i < 2; ++i) { const int e = tid + 512 * i, row = e >> 4, ch = e & 15; *(LAS u32x4*)(OST + 256 * row + 16 * ch) = p_q[i]; *(LAS u32x4*)(OST + 16384 + 256 * row + 16 * ch) = p_k[i]; }
        __syncthreads();
        if (unit + G < GLA_UNITS) GLA1_ISSUE(unit + G);
        unsigned qk[16];
#pragma unroll
        for (int i = 0; i < 16; ++i) { const int o2 = 256 * (16 * seg + i) + 2 * dch; qk[i] = (unsigned)*(const LAS unsigned short*)(OST + o2) | ((unsigned)*(const LAS unsigned short*)(OST + 16384 + o2) << 16); }
        float cum[16]; float run = 0.f; float zz[16];
#pragma unroll
        for (int i = 0; i < 16; ++i) zz[i] = WU[16 * 128 + dch];
#pragma unroll
        for (int r4 = 0; r4 < 4; ++r4) { const float w0 = WU[(4 * r4) * 128 + dch], w1 = WU[(4 * r4 + 1) * 128 + dch], w2 = WU[(4 * r4 + 2) * 128 + dch], w3 = WU[(4 * r4 + 3) * 128 + dch];
#pragma unroll
            for (int i = 0; i < 16; ++i) { const f32x4 av = *(const LAS f32x4*)(ABS + (16 * seg + i) * 16 + 4 * r4); zz[i] += (av[0] * w0 + av[1] * w1) + (av[2] * w2 + av[3] * w3); } }
#pragma unroll
        for (int i = 0; i < 16; ++i) { const float z = zz[i];
            const float la = (fminf(z, 0.f) - __logf(1.f + __expf(-fabsf(z)))) * 0.0625f; run += la; cum[i] = run; }
        SEG[seg * 128 + dch] = run;
        __syncthreads();
        float pre = 0.f, tot = 0.f;
#pragma unroll
        for (int s_ = 0; s_ < 4; ++s_) { const float v = SEG[s_ * 128 + dch]; tot += v; if (s_ < seg) pre += v; }
#pragma unroll
        for (int i = 0; i < 16; ++i) { const int t = 16 * seg + i; const float bi = pre + cum[i]; const float eb = __expf(bi), ebi = __builtin_amdgcn_rcpf(eb);
            const float qv = __uint_as_float(qk[i] << 16), kv = __uint_as_float(qk[i] & 0xffff0000u);
            const int o = 256 * t + 16 * ((dch >> 3) ^ (t & 15)) + 2 * (dch & 7);
            const unsigned me = pk2(qv * eb, kv * ebi), nb = (unsigned)__shfl_xor((int)me, 1);
            if (!(dch & 1)) { *(LAS unsigned*)(QT + o) = (me & 0xffffu) | (nb << 16); *(LAS unsigned*)(KT + o) = (me >> 16) | (nb & 0xffff0000u); } }
        if (seg == 3) BLG[(size_t)unit * 128 + dch] = __expf(tot);
        __syncthreads();
#pragma unroll
        for (int i = 0; i < 2; ++i) { const int e = tid + 512 * i, row = e >> 4, ch = e & 15; bf16_t* dst = bufB + (tok0 + row) * 2048 + h * 128 + ch * 8;
            *(u32x4*)dst = *(const LAS u32x4*)(QT + 256 * row + 16 * ch); *(u32x4*)(dst + 512) = *(const LAS u32x4*)(KT + 256 * row + 16 * ch); } }
    }
#undef GLA1_ISSUE
#undef GLA_IDS
}
DI void gla2_phase(LAS unsigned char* lds, const bf16_t* bufB, bf16_t* RB, const float* BLG, const float* gn, int bid, int G) {
    int tid_raw = threadIdx.x; asm volatile("" : "+v"(tid_raw));
    const int w = __builtin_amdgcn_readfirstlane(tid_raw >> 6);
#define GLA_IDS() int tid = tid_raw; asm volatile("" : "+v"(tid)); const int lane = tid & 63, l31 = lane & 31, h2 = lane >> 5, q4 = (lane & 15) >> 2, p4 = lane & 3, blk = (lane >> 4) & 1; (void)l31; (void)h2; (void)q4; (void)p4; (void)blk
    LAS unsigned char* QT = lds + G_QT; LAS unsigned char* KT = lds + G_KT; LAS unsigned char* VT = lds + G_VT; LAS unsigned char* OST = lds + G_OST;
    LAS float* BL = (LAS float*)(lds + G_BL); LAS float* GN = (LAS float*)(lds + G_GN);
    for (int st = bid; st < 64; st += G) {
        const int b = st >> 2, h = st & 3;
        __syncthreads();
        { GLA_IDS(); if (tid < 256) GN[tid] = gn[tid]; }
        f32x16 S[4];
#pragma unroll
        for (int i = 0; i < 4; ++i) S[i] = (f32x16){};
        u32x4 pq[2], pk[2], pv[4]; float pa = 0.f;
        { GLA_IDS(); const size_t tok0 = (size_t)b * SEQ;
#pragma unroll
            for (int i = 0; i < 2; ++i) { const int e = tid + 512 * i, row = e >> 4, ch = e & 15; const bf16_t* src = bufB + (tok0 + row) * 2048 + h * 128 + ch * 8; pq[i] = *(const u32x4*)src; pk[i] = *(const u32x4*)(src + 512); }
#pragma unroll
            for (int i = 0; i < 4; ++i) { const int e = tid + 512 * i, row = e >> 5, ch = e & 31; pv[i] = *(const u32x4*)(bufB + (tok0 + row) * 2048 + 1024 + h * 256 + ch * 8); }
            if (tid < 128) pa = BLG[(size_t)(st * 32) * 128 + tid]; }
#pragma nounroll
        for (int c = 0; c < 32; ++c) {
            const size_t tok0 = (size_t)b * SEQ + c * 64;
            u32x4 gate[4];
            { GLA_IDS();
#pragma unroll
            for (int i = 0; i < 2; ++i) { const int e = tid + 512 * i, row = e >> 4, ch = e & 15; *(LAS u32x4*)(QT + 256 * row + 16 * ch) = pq[i]; *(LAS u32x4*)(KT + 256 * row + 16 * ch) = pk[i]; }
#pragma unroll
            for (int i = 0; i < 4; ++i) { const int e = tid + 512 * i, row = e >> 5, ch = e & 31; *(LAS u32x4*)(VT + 512 * row + 16 * (ch ^ (row & 15))) = pv[i]; }
            if (tid < 128) BL[tid] = pa;
            __syncthreads();
            if (c + 1 < 32) { const size_t tn = tok0 + 64;
#pragma unroll
                for (int i = 0; i < 2; ++i) { const int e = tid + 512 * i, row = e >> 4, ch = e & 15; const bf16_t* src = bufB + (tn + row) * 2048 + h * 128 + ch * 8; pq[i] = *(const u32x4*)src; pk[i] = *(const u32x4*)(src + 512); }
#pragma unroll
                for (int i = 0; i < 4; ++i) { const int e = tid + 512 * i, row = e >> 5, ch = e & 31; pv[i] = *(const u32x4*)(bufB + (tn + row) * 2048 + 1024 + h * 256 + ch * 8); }
                if (tid < 128) pa = BLG[(size_t)(st * 32 + c + 1) * 128 + tid]; }
            bf16x8 vf[4];
#pragma unroll
            for (int k4 = 0; k4 < 4; ++k4) { const int row0 = 16 * k4 + 4 * h2 + q4, row1 = row0 + 8, chunk = 4 * w + 2 * blk + (p4 >> 1);
                const s16x4 lo = vtr(VT + 512 * row0 + 16 * (chunk ^ (row0 & 15)) + 8 * (p4 & 1));
                const s16x4 hi = vtr(VT + 512 * row1 + 16 * (chunk ^ (row1 & 15)) + 8 * (p4 & 1)); vf[k4] = cat8(lo, hi); }
#pragma unroll
            for (int tb = 0; tb < 2; ++tb) {
                f32x16 acc = zero16();
                const int t = 32 * tb + l31, tsw = t & 15; const LAS unsigned char* qrow = QT + 256 * t;
#pragma unroll
                for (int dkb = 0; dkb < 4; ++dkb) { const bf16x8 sf0 = pack8(S[dkb], 0), sf1 = pack8(S[dkb], 1);
#pragma unroll
                    for (int ks = 0; ks < 2; ++ks) { const int ch0 = 4 * dkb + 2 * ks;
                        const s16x4 lo = *(const LAS s16x4*)(qrow + 16 * (ch0 ^ tsw) + 8 * h2), hi = *(const LAS s16x4*)(qrow + 16 * ((ch0 + 1) ^ tsw) + 8 * h2);
                        acc = MFMA32(cat8(lo, hi), ks == 0 ? sf0 : sf1, acc); } }
#pragma unroll
                for (int sb = 0; sb <= tb; ++sb) { f32x16 X = zero16(); const int srow = 32 * sb + l31, ssw = srow & 15; const LAS unsigned char* krow_ = KT + 256 * srow;
#pragma unroll
                    for (int ks = 0; ks < 8; ++ks) { const bf16x8 av = *(const LAS bf16x8*)(krow_ + 16 * ((2 * ks + h2) ^ ssw)), bv = *(const LAS bf16x8*)(qrow + 16 * ((2 * ks + h2) ^ tsw)); X = MFMA32(av, bv, X); }
                    if (sb == tb) {
#pragma unroll
                        for (int reg = 0; reg < 16; ++reg) if (crow(reg, h2) > l31) X[reg] = 0.f; }
                    acc = MFMA32(pack8(X, 0), vf[2 * sb], acc); acc = MFMA32(pack8(X, 1), vf[2 * sb + 1], acc); }
#pragma unroll
                for (int reg = 0; reg < 16; ++reg) *(LAS unsigned short*)(OST + 512 * (32 * tb + crow(reg, h2)) + 2 * (32 * w + l31)) = (unsigned short)pk2(acc[reg], 0.f);
            }
            { const int t = tid >> 3, s8 = tid & 7; const bf16_t* rp = RB + (tok0 + t) * 1024 + h * 256 + 32 * s8;
#pragma unroll
                for (int i = 0; i < 4; ++i) gate[i] = *(const u32x4*)(rp + 8 * i); }
#pragma unroll
            for (int dkb = 0; dkb < 4; ++dkb) {
#pragma unroll
                for (int k4 = 0; k4 < 4; ++k4) { const int key0 = 16 * k4 + 4 * h2 + q4, key1 = key0 + 8, chunk = 4 * dkb + 2 * blk + (p4 >> 1);
                    const s16x4 lo = vtr(KT + 256 * key0 + 16 * (chunk ^ (key0 & 15)) + 8 * (p4 & 1));
                    const s16x4 hi = vtr(KT + 256 * key1 + 16 * (chunk ^ (key1 & 15)) + 8 * (p4 & 1));
                    S[dkb] = MFMA32(cat8(lo, hi), vf[k4], S[dkb]); }
#pragma unroll
                for (int rg = 0; rg < 4; ++rg) { const f32x4 dv = *(const LAS f32x4*)(BL + 32 * dkb + 8 * rg + 4 * h2);
                    S[dkb][4 * rg] *= dv[0]; S[dkb][4 * rg + 1] *= dv[1]; S[dkb][4 * rg + 2] *= dv[2]; S[dkb][4 * rg + 3] *= dv[3]; }
            }
            }
            __syncthreads();
            { GLA_IDS(); const int t = tid >> 3, s8 = tid & 7; const LAS u32x4* orow = (const LAS u32x4*)(OST + 512 * t + 64 * s8);
                f32x4 ov[8]; float ss = 0.f;
#pragma unroll
                for (int i = 0; i < 4; ++i) { unpk8(orow[i], ov[2 * i], ov[2 * i + 1]); }
#pragma unroll
                for (int i = 0; i < 8; ++i) ss += (ov[i][0] * ov[i][0] + ov[i][1] * ov[i][1]) + (ov[i][2] * ov[i][2] + ov[i][3] * ov[i][3]);
                ss += __shfl_xor(ss, 1); ss += __shfl_xor(ss, 2); ss += __shfl_xor(ss, 4);
                const float rn = rsqrtf(ss * (1.f / 256.f) + EPS);
                bf16_t* rp = RB + (tok0 + t) * 1024 + h * 256 + 32 * s8;
#pragma unroll
                for (int i = 0; i < 4; ++i) { f32x4 ra, rb2; unpk8(gate[i], ra, rb2);
                    const f32x4 g0 = *(const LAS f32x4*)(GN + 32 * s8 + 8 * i), g1 = *(const LAS f32x4*)(GN + 32 * s8 + 8 * i + 4);
                    *(u32x4*)(rp + 8 * i) = pk8(ov[2 * i] * rn * g0 * ra, ov[2 * i + 1] * rn * g1 * rb2); } }
        }
    }
#undef GLA_IDS
}
#define XB_TMO      128
#define XB_XCNT(j)  (256  + 64 * (j))
#define XB_XSUB(j)  (1280 + 64 * (j))
#define XB_XGEN(j)  (2304 + 64 * (j))
#define XB_TOP      3328
#define XB_TOPGEN   3392
#define XCD_BAR_WORDS 3456
#define XB_SPIN_CAP (1u << 18)

__device__ __forceinline__ unsigned xb_ld(unsigned* p)              { return __hip_atomic_load(p, __ATOMIC_RELAXED, __HIP_MEMORY_SCOPE_AGENT); }
__device__ __forceinline__ unsigned xb_add(unsigned* p, unsigned v) { return __hip_atomic_fetch_add(p, v, __ATOMIC_RELAXED, __HIP_MEMORY_SCOPE_AGENT); }
__device__ __forceinline__ unsigned xb_xcc_id() { return (unsigned)__builtin_amdgcn_s_getreg((3 << 11) | 20) & 0xFu; }
#define XB_SPIN(cond, bar) do { unsigned _sp = 0; while (cond) { __builtin_amdgcn_s_sleep(1); \
    if ((++_sp & 255u) == 0u) { if (xb_ld(&(bar)[XB_TMO])) break; if (_sp > XB_SPIN_CAP) { atomicAdd(&(bar)[XB_TMO], 1u); break; } } } } while (0)

struct XcdBarrier {
    unsigned* bar; unsigned x;
    volatile LAS unsigned* st;
};

__device__ __forceinline__ XcdBarrier xcd_barrier_post(unsigned* bar, volatile LAS unsigned* st) {
    XcdBarrier b; b.bar = bar; b.x = xb_xcc_id(); b.st = st;
    if (threadIdx.x == 0) (void)xb_add(&bar[XB_XCNT(b.x)], 1u);
    return b;
}
__device__ __forceinline__ void xcd_barrier_complete(unsigned* bar, unsigned x, unsigned& nloc, unsigned& nx) {
    const unsigned G = gridDim.x * gridDim.y * gridDim.z;
    unsigned sum, cnt, mine, sp = 0u;
    for (;;) {
        sum = 0u; cnt = 0u; mine = 0u;
#pragma unroll
        for (unsigned j = 0; j < 16; ++j) { const unsigned c = xb_ld(&bar[XB_XCNT(j)]); sum += c; cnt += (c > 0u) ? 1u : 0u; mine = (j == x) ? c : mine; }
        if (sum == G) break;
        __builtin_amdgcn_s_sleep(1);
        if ((++sp & 255u) == 0u) { if (xb_ld(&bar[XB_TMO])) break; if (sp > XB_SPIN_CAP) { atomicAdd(&bar[XB_TMO], 1u); break; } }
    }
    nloc = mine > 0u ? mine : 1u; nx = cnt > 0u ? cnt : 1u;
}

__device__ __forceinline__ void xcd_barrier(const XcdBarrier& b) {
    asm volatile("s_waitcnt vmcnt(0)" ::: "memory");
    __syncthreads();
    if (threadIdx.x == 0) {
        unsigned* bar = b.bar;
        __builtin_amdgcn_s_waitcnt(0);
        unsigned nloc = b.st[0], nx = b.st[1];
        if (nloc == 0u) { xcd_barrier_complete(bar, b.x, nloc, nx); b.st[0] = nloc; b.st[1] = nx; }
        const unsigned old = xb_add(&bar[XB_XSUB(b.x)], 1u);
        const unsigned gen = old / nloc;
        if (old + 1u == (gen + 1u) * nloc) {
            __builtin_amdgcn_fence(__ATOMIC_RELEASE, "agent");
            asm volatile("s_waitcnt vmcnt(0)" ::: "memory");
            const unsigned og = xb_add(&bar[XB_TOP], 1u);
            const unsigned tg = og / nx;
            if (og + 1u == (tg + 1u) * nx) xb_add(&bar[XB_TOPGEN], 1u);
            else XB_SPIN(xb_ld(&bar[XB_TOPGEN]) == tg, bar);
            __builtin_amdgcn_fence(__ATOMIC_ACQUIRE, "agent");
            xb_add(&bar[XB_XGEN(b.x)], 1u);
            asm volatile("s_waitcnt vmcnt(0)" ::: "memory");
        } else {
            XB_SPIN(xb_ld(&bar[XB_XGEN(b.x)]) == gen, bar);
            __builtin_amdgcn_fence(__ATOMIC_ACQUIRE, "agent");
            asm volatile("s_waitcnt vmcnt(0)" ::: "memory");
        }
    }
    __syncthreads();
}

__global__ void __launch_bounds__(512, 2) hybrid_fwd(Args a) {
    extern __shared__ __attribute__((aligned(16))) unsigned char lds_raw[];
    LAS unsigned char* lds = (LAS unsigned char*)lds_raw;
    cg::grid_group grid = cg::this_grid();
#define GRID_SYNC_CG() do { asm volatile("s_waitcnt vmcnt(0)" ::: "memory"); grid.sync(); asm volatile("s_waitcnt vmcnt(0)" ::: "memory"); __builtin_amdgcn_s_barrier(); asm volatile("" ::: "memory"); } while (0)
#define GRID_SYNC() xcd_barrier(xbar)
    const int wave = __builtin_amdgcn_readfirstlane((int)threadIdx.x >> 6);
    const int bid = blockIdx.x, G = gridDim.x;
    volatile LAS unsigned* xst = (volatile LAS unsigned*)(lds + LDS_BYTES - 64);
    if (threadIdx.x < 2) xst[threadIdx.x] = 0u;
    __syncthreads();
    const XcdBarrier xbar = xcd_barrier_post((unsigned*)(a.ws + WS_BAR), xst);
    unsigned char* ws = a.ws;
#define XB ((bf16_t*)(ws + WS_XB))
#define OG ((bf16_t*)(ws + WS_R + R_OG))
#define BUFA ((bf16_t*)(ws + WS_R + R_BUFA))
#define BUFB ((bf16_t*)(ws + WS_R + R_BUFB))
#define RBB ((bf16_t*)(ws + WS_R + R_RB))
#define GA8 ((unsigned char*)(ws + WS_R + R_GA))
#define GB8 ((unsigned char*)(ws + WS_R + R_GA + 32 * MiB))
#define YB ((bf16_t*)(ws + WS_GB))
#define HB ((bf16_t*)(ws + WS_R + R_HB))
#define ROPE ((float*)(ws + WS_ROPE))
#define ABUF ((float*)(ws + WS_AB))
#define DEN ((float*)(ws + WS_DEN))
    float* xout = a.out;
    LAS float* cscr = (LAS float*)(lds + wave * 8704);

    {
        float* ROWSS = (float*)(ws + WS_ROWSS);
        int tid = threadIdx.x; asm volatile("" : "+v"(tid)); const int lane = tid & 63;
        const int gw = bid * 8 + wave, ngw = G * 8;
        conv_layer(a, 0, ws, cscr, gw, ngw);
        const float* x = a.in[0];
        for (int m = gw; m < T; m += ngw) { const f32x4* xr = (const f32x4*)(x + (size_t)m * 1024) + lane; float s = 0.f; u32x2* o8 = (u32x2*)(XB + (size_t)m * 1024) + lane;
#pragma unroll
            for (int j = 0; j < 4; ++j) { const f32x4 v = xr[64 * j]; s += (v[0] * v[0] + v[1] * v[1]) + (v[2] * v[2] + v[3] * v[3]); u32x2 o; o.x = pk2(v[0], v[1]); o.y = pk2(v[2], v[3]); o8[64 * j] = o; }
            s = wave_sum(s); if (lane < 16) ROWSS[(size_t)m * 16 + lane] = (lane == 0) ? s : 0.f; }
        const size_t gt = (size_t)bid * 512 + tid, ngt = (size_t)G * 512;
        const int* pos = (const int*)a.in[1];
        for (size_t i = gt; i < (size_t)T * 64; i += ngt) { const int t = (int)(i >> 6), f = (int)(i & 63);
            const float inv_freq = powf(10000.f, -(float)(2 * f) / 128.f); const float ang = (float)pos[t] * inv_freq;
            double rev = (double)ang * 0.15915494309189535; rev -= floor(rev); const float fr = (float)rev;
            typedef _Float16 h2_t __attribute__((ext_vector_type(2))); const h2_t hv = {(_Float16)__builtin_amdgcn_cosf(fr), (_Float16)__builtin_amdgcn_sinf(fr)};
            ((unsigned*)ROPE)[i] = __builtin_bit_cast(unsigned, hv); }
    }
    GRID_SYNC_CG();

    for (int l0 = 0; l0 < DEPTH; ++l0) {
#define PHASE_PTRS() int l = l0; asm volatile("" : "+s"(l)); unsigned char* wb = ws + (size_t)(l & 1) * W_LAYER; float* ROWSS = (float*)(ws + WS_ROWSS); \
        const float* ss1 = ROWSS; float* ss2 = ROWSS + (size_t)T * 16; float* ss1n = ROWSS; (void)wb; (void)ss1; (void)ss2; (void)ss1n
        { PHASE_PTRS(); Gemm g{XB, (const bf16_t*)(wb + W_INA), T, 2560, 1024}; StaticOrder S; S.init(T, 2560, G, bid);
          EpiInA E{BUFA, ss1, a.in[4] + l * 128, a.in[5] + l * 128, ROPE, (LAS float*)(lds + EPI_LDS), QSCALE};
#ifndef NO_G1
          gemm_phase<EpiInA, StaticOrder, true, true>(lds, g, S, E);
#endif
        }
        GRID_SYNC();
#ifndef NO_ATTN
        attn_phase(lds, (const bf16_t*)(ws + WS_R + R_BUFA), (bf16_t*)(ws + WS_R + R_OG), (float*)(ws + WS_DEN), (G % 8 == 0) ? (bid % 8) * (G / 8) + bid / 8 : bid, G);
#endif
        GRID_SYNC();
        { PHASE_PTRS(); ab_task(XB, (const bf16_t*)(wb + W_INB) + (size_t)3072 * 1024, ss1, ABUF, bid, G);
          Gemm g{XB, (const bf16_t*)(wb + W_INB), T, 3072, 1024}; StaticOrder S; S.init(T, 3072, G, bid);
          EpiInB E{BUFB, RBB, ABUF, ss1, (LAS float*)(lds + EPI_LDS) + 2048};
#ifndef NO_G2
          gemm_phase<EpiInB, StaticOrder, true, true>(lds, g, S, E);
#endif
        }
        GRID_SYNC();
        { PHASE_PTRS();
          combine_pass(OG, DEN, bid, G);
#ifndef NO_GLA
          gla1_phase(lds, BUFB, ABUF, a.in[6] + (size_t)l * 16 * 512, a.in[7] + l * 512, (float*)(ws + WS_BLG), bid, G);
#endif
        }
        GRID_SYNC();
        { PHASE_PTRS();
#ifndef NO_GLA
        if (G <= 64 || bid < 64) gla2_phase(lds, BUFB, RBB, (const float*)(ws + WS_BLG), a.in[8] + l * 256, bid, G <= 64 ? G : 64);
#endif
        if (G <= 64 || bid >= 64) { const int hid = G <= 64 ? bid : bid - 64, HN = G <= 64 ? G : G - 64;
            __syncthreads();
            if (l + 1 < DEPTH) conv_layer(a, l + 1, ws + (size_t)((l + 1) & 1) * W_LAYER, cscr, hid * 8 + wave, HN * 8);
            __syncthreads();
            Gemm g{XB, (const bf16_t*)(wb + W_INC), T, 2048, 1024}; StaticOrder S; S.init(T, 2048, HN, hid);
            EpiInC E{GA8, GB8, ss1, (LAS float*)(lds + EPI_LDS) + 2048};
#ifndef NO_G3
            gemm_phase<EpiInC, StaticOrder, true, true>(lds, g, S, E);
#endif
        } }
        GRID_SYNC();
        { PHASE_PTRS(); Gemm g{OG, (const bf16_t*)(wb + W_PA), T, 1024, 512}; StaticOrder S; S.init(T, 1024, G, bid);
          EpiProj<0> E{YB, GA8};
#ifndef NO_G4
          gemm_phase<EpiProj<0>, StaticOrder, true, true>(lds, g, S, E);
#endif
        }
        { PHASE_PTRS(); Gemm g{RBB, (const bf16_t*)(wb + W_PB), T, 1024, 1024}; StaticOrder S; S.init(T, 1024, G, bid);
          EpiProj<1> E{YB, GB8};
#ifndef NO_G5
          gemm_phase<EpiProj<1>, StaticOrder, true, true>(lds, g, S, E);
#endif
        }
        GRID_SYNC();
        { PHASE_PTRS(); Gemm g{YB, (const bf16_t*)(wb + W_OUT), T, 1024, 1024}; StaticOrder S; S.init(T, 1024, G, bid);
          EpiRes<0> E{l == 0 ? a.in[0] : xout, xout, XB, (bf16_t*)(ws + WS_R + R_GA), ss2, 0};
#ifndef NO_G6
          gemm_phase<EpiRes<0>, StaticOrder, true, true>(lds, g, S, E);
#endif
        }
        GRID_SYNC();
        { PHASE_PTRS(); Gemm g{XB, (const bf16_t*)(wb + W_GU), T, 5632, 1024}; StaticOrder S; S.init(T, 5632, G, bid);
          EpiFFN E{HB, ss2, (LAS float*)(lds + EPI_LDS) + 2048};
#ifndef NO_G7
          gemm_phase<EpiFFN, StaticOrder, true, true>(lds, g, S, E);
#endif
        }
        GRID_SYNC();
        { PHASE_PTRS(); Gemm g{HB, (const bf16_t*)(wb + W_D), T, 1024, 2816}; StaticOrder S; S.init(T, 1024, G, bid);
          EpiRes<1> E{xout, xout, XB, (bf16_t*)(ws + WS_R + R_GA), ss1n, l + 1 == DEPTH};
#ifndef NO_G8
          gemm_phase<EpiRes<1>, StaticOrder, true, true>(lds, g, S, E);
#endif
        }
        if (l0 + 1 < DEPTH) GRID_SYNC();
    }
}

extern "C" void kernel_launch(void* const* d_in, const int* in_sizes, int n_in, void* d_out, int out_size, void* d_ws, size_t ws_size, hipStream_t stream) {
    static int grid = 0;
    if (grid == 0) {
        if (n_in != 16 || out_size != T * 1024 || ws_size < WS_END) { fprintf(stderr, "kernel_launch: unexpected shapes (n_in %d, out %d, ws %zu)\n", n_in, out_size, ws_size); grid = -1; return; }
        int dev = 0, cus = 0, per_cu = 0;
        hipGetDevice(&dev); hipDeviceGetAttribute(&cus, hipDeviceAttributeMultiprocessorCount, dev);
        hipFuncSetAttribute((const void*)hybrid_fwd, hipFuncAttributeMaxDynamicSharedMemorySize, LDS_BYTES);
        hipOccupancyMaxActiveBlocksPerMultiprocessor(&per_cu, (const void*)hybrid_fwd, 512, LDS_BYTES);
        if (per_cu < 1) per_cu = 1;
        (void)hipGetLastError();
        grid = cus * per_cu;
    }
    if (grid < 0) return;
    if (hipMemsetAsync((char*)d_ws + WS_BAR, 0, 16384, stream) != hipSuccess) { fprintf(stderr, "kernel_launch: memset of the barrier words failed\n"); return; }
    Args a{};
    for (int i = 0; i < 16; ++i) a.in[i] = (const float*)d_in[i];
    a.out = (float*)d_out; a.ws = (unsigned char*)d_ws;
    void* args[] = {&a};
    hipError_t e = hipLaunchCooperativeKernel((const void*)hybrid_fwd, dim3(grid), dim3(512), args, LDS_BYTES, stream);
    if (e != hipSuccess) fprintf(stderr, "cooperative launch failed: %s (grid %d)\n", hipGetErrorString(e), grid);
}
```
